# Optimizing an MI355X kernel written in HIP

```python
import jax, jax.numpy as jnp
from jax import lax
import numpy as np

D_MODEL = 2048
BATCH = 2
SEQ = 16384
DEPTH = 2

GRID_W = 64
NA_HEADS = 8
NA_HEAD_DIM = 128
NA_WIDTH = NA_HEADS * NA_HEAD_DIM
NA_MAX_ROWS = 8
NA_COLS = 16
SG_GROUPS = 8
SG_GROUP_DIM = 128
SG_WIDTH = SG_GROUPS * SG_GROUP_DIM
SG_CHUNK = 128
SPLIT_WIDTHS = (NA_WIDTH, NA_WIDTH, NA_WIDTH, NA_WIDTH, SG_WIDTH, SG_WIDTH, SG_WIDTH, D_MODEL, D_MODEL)
N_IN = sum(SPLIT_WIDTHS)
SPLIT_POINTS = tuple(int(s) for s in np.cumsum(SPLIT_WIDTHS)[:-1])
RMS_EPS = 1e-6
LN_EPS = 1e-5

kernel_name = "hybrid_natten_gmlp_encoder"


def rms_norm(x, g):
    xf = x.astype(jnp.float32)
    y = xf * lax.rsqrt(jnp.mean(xf * xf, axis=-1, keepdims=True) + RMS_EPS)
    return (y * g.astype(jnp.float32)).astype(x.dtype)


def layer_norm(x, g, b):
    xf = x.astype(jnp.float32)
    mu = jnp.mean(xf, axis=-1, keepdims=True)
    xc = xf - mu
    var = jnp.mean(xc * xc, axis=-1, keepdims=True)
    y = xc * lax.rsqrt(var + LN_EPS) * g.astype(jnp.float32) + b.astype(jnp.float32)
    return y.astype(x.dtype)


def neighbourhood_attention(q, k, v, rpb, rows):
    kr = min(NA_MAX_ROWS, rows)
    col = jnp.arange(GRID_W)
    col_start = jnp.clip(col - NA_COLS // 2, 0, GRID_W - NA_COLS)
    col_idx = col_start[:, None] + jnp.arange(NA_COLS)[None, :]
    dc = col_idx - col[:, None] + (NA_COLS - 1)
    rpb_c = rpb[:, :, dc]
    scale = NA_HEAD_DIM ** -0.5
    b = q.shape[0]

    def one_row(r):
        rs = jnp.clip(r - kr // 2, 0, rows - kr)
        k_rows = lax.dynamic_slice_in_dim(k, rs, kr, axis=1)
        v_rows = lax.dynamic_slice_in_dim(v, rs, kr, axis=1)
        k_win = k_rows[:, :, col_idx]
        v_win = v_rows[:, :, col_idx]
        q_r = lax.dynamic_index_in_dim(q, r, axis=1, keepdims=False)
        dr = rs + jnp.arange(kr) - r + (NA_MAX_ROWS - 1)
        bias = rpb_c[:, dr].transpose(0, 2, 1, 3)
        s = jnp.einsum('bqhd,bkqchd->bhqkc', q_r, k_win).astype(jnp.float32) * scale
        s = s + bias[None].astype(jnp.float32)
        p = jax.nn.softmax(s.reshape(b, NA_HEADS, GRID_W, kr * NA_COLS), axis=-1)
        p = p.reshape(s.shape).astype(v.dtype)
        return jnp.einsum('bhqkc,bkqchd->bqhd', p, v_win)

    out = lax.map(one_row, jnp.arange(rows))
    return out.transpose(1, 0, 2, 3, 4)


def spatial_gating(u, v, ln_g, ln_b, w_s, b_s):
    b, t, _ = v.shape
    v = layer_norm(v, ln_g, ln_b)
    vc = v.reshape(b, t // SG_CHUNK, SG_CHUNK, SG_GROUPS, SG_GROUP_DIM)
    s = jnp.einsum('gst,bntgc->bnsgc', w_s, vc) + b_s.T[None, None, :, :, None]
    return u * s.reshape(b, t, SG_WIDTH)


def hybrid_layer(x, pre_g, post_g, w_in, rpb, ln_g, ln_b, w_s, b_s, w_pa, w_pb, w_out):
    b, t, _ = x.shape
    rows = t // GRID_W
    h = rms_norm(x, pre_g)
    proj = jnp.einsum('btd,dn->btn', h, w_in)
    q, k, v, z_a, u, vs, z_b, g_a, g_b = jnp.split(proj, SPLIT_POINTS, axis=-1)
    grid = (b, rows, GRID_W, NA_HEADS, NA_HEAD_DIM)
    y_a = neighbourhood_attention(q.reshape(grid), k.reshape(grid), v.reshape(grid), rpb, rows)
    y_a = y_a.reshape(b, t, NA_WIDTH) * jax.nn.silu(z_a)
    y_b = spatial_gating(u, vs, ln_g, ln_b, w_s, b_s) * jax.nn.silu(z_b)
    merged = (jax.nn.sigmoid(g_a) * jnp.einsum('btc,cd->btd', y_a, w_pa)
              + jax.nn.sigmoid(g_b) * jnp.einsum('btc,cd->btd', y_b, w_pb))
    out = jnp.einsum('btd,de->bte', merged, w_out)
    return x + rms_norm(out, post_g)


def setup_inputs(seed: int = 0) -> dict:
    key = jax.random.key(seed)
    ks = jax.random.split(key, 14)
    f32 = jnp.float32
    n = lambda k, shape: jax.random.normal(k, shape, f32)
    return {
        "x": n(ks[0], (BATCH, SEQ, D_MODEL)),
        "pre_norm_g": 1.0 + 0.02 * n(ks[1], (DEPTH, D_MODEL)),
        "post_norm_g": 1.0 + 0.02 * n(ks[2], (DEPTH, D_MODEL)),
        "w_in": n(ks[3], (DEPTH, D_MODEL, N_IN)) * D_MODEL ** -0.5,
        "na_rpb": 0.1 * n(ks[4], (DEPTH, NA_HEADS, 2 * NA_MAX_ROWS - 1, 2 * NA_COLS - 1)),
        "sg_ln_g": 1.0 + 0.02 * n(ks[5], (DEPTH, SG_WIDTH)),
        "sg_ln_b": 0.02 * n(ks[6], (DEPTH, SG_WIDTH)),
        "sg_w": n(ks[7], (DEPTH, SG_GROUPS, SG_CHUNK, SG_CHUNK)) * SG_CHUNK ** -0.5,
        "sg_b": 1.0 + 0.02 * n(ks[8], (DEPTH, SG_GROUPS, SG_CHUNK)),
        "w_proj_a": n(ks[9], (DEPTH, NA_WIDTH, D_MODEL)) * NA_WIDTH ** -0.5,
        "w_proj_b": n(ks[10], (DEPTH, SG_WIDTH, D_MODEL)) * SG_WIDTH ** -0.5,
        "w_out": n(ks[11], (DEPTH, D_MODEL, D_MODEL)) * D_MODEL ** -0.5,
    }


def reference(x, pre_norm_g, post_norm_g, w_in, na_rpb, sg_ln_g, sg_ln_b, sg_w, sg_b,
              w_proj_a, w_proj_b, w_out):
    for l in range(DEPTH):
        x = hybrid_layer(x, pre_norm_g[l], post_norm_g[l], w_in[l], na_rpb[l], sg_ln_g[l],
                         sg_ln_b[l], sg_w[l], sg_b[l], w_proj_a[l], w_proj_b[l], w_out[l])
    return x
```

```cpp
#include <hip/hip_runtime.h>
#include <hip/hip_cooperative_groups.h>
#include <cstdio>
#include <cstdint>
namespace cg = cooperative_groups;

#define LAS __attribute__((address_space(3)))
typedef unsigned short bf16_t;
typedef short bf16x8 __attribute__((ext_vector_type(8)));
typedef float f32x4 __attribute__((ext_vector_type(4)));
typedef unsigned u32x4 __attribute__((ext_vector_type(4)));
typedef unsigned u32x2 __attribute__((ext_vector_type(2)));

constexpr int DM = 2048, NTOK = 32768, SEQ = 16384, NIN = 11264, DEPTH = 2;
constexpr int NP = 9216;
constexpr int Q_OFF = 0, K_OFF = 1024, ZA_OFF = 2048, U_OFF = 3072, ZB_OFF = 4096, GA_OFF = 5120, GB_OFF = 7168;
constexpr int RPB_N = 8 * 15 * 31;
constexpr size_t SZ_WIN = (size_t)NIN * DM * 2, SZ_WP = (size_t)DM * 1024 * 2, SZ_WOUT = (size_t)DM * DM * 2, SZ_SGW = (size_t)8 * 128 * 128 * 2;
constexpr size_t OFF_WIN = 0, OFF_WPA = OFF_WIN + SZ_WIN, OFF_WPB = OFF_WPA + SZ_WP, OFF_WOUT = OFF_WPB + SZ_WP, OFF_SGW = OFF_WOUT + SZ_WOUT, SZ_LAYER_W = OFF_SGW + SZ_SGW;
constexpr size_t WS_W = 0, WS_H = WS_W + DEPTH * SZ_LAYER_W, WS_VT = WS_H + (size_t)NTOK * DM * 2, WS_PROJ = WS_VT + (size_t)2048 * NTOK * 2,
                 WS_BAR = WS_PROJ + (size_t)NTOK * NP * 2, WS_KT = WS_BAR + 16384, WS_END = WS_KT + (size_t)NTOK * 1024 * 2;
constexpr int LDS_BYTES = 131072 + 64;

struct Params {
    const float* x; const float* pre_g; const float* post_g; const float* w_in; const float* rpb; const float* ln_g; const float* ln_b;
    const float* sg_w; const float* sg_b; const float* w_pa; const float* w_pb; const float* w_out; float* out; unsigned char* ws;
};

__device__ __forceinline__ unsigned f2bf(float f) { unsigned u = __builtin_bit_cast(unsigned, f); return (u + 0x7fffu + ((u >> 16) & 1u)) >> 16; }
__device__ __forceinline__ unsigned cvt_pk_bf16(float lo, float hi) { unsigned r; asm volatile("v_cvt_pk_bf16_f32 %0, %1, %2" : "=v"(r) : "v"(lo), "v"(hi)); return r; }
__device__ __forceinline__ float bflo(unsigned w) { return __builtin_bit_cast(float, w << 16); }
__device__ __forceinline__ float bfhi(unsigned w) { return __builtin_bit_cast(float, w & 0xffff0000u); }
__device__ __forceinline__ float sigmoidf_(float v) { return __builtin_amdgcn_rcpf(1.0f + __expf(-v)); }
__device__ __forceinline__ float siluf_(float v) { return v * sigmoidf_(v); }

namespace pg8 {
constexpr int BM = 256, BK = 64, HALF = 128, HTB = HALF * BK * 2, STAGE_BYTES = 8 * HTB, NXCD = 8, WGM = 8;
__host__ __device__ __forceinline__ int lds_byte(int r, int c) { const int st = (r >> 4) * 2 + (c >> 5), rr = r & 15, cc = c & 31, ob = rr * 64 + cc * 2; return st * 1024 + (ob ^ (((ob >> 9) & 1) << 5)); }
__host__ __device__ __forceinline__ void stage_rc(int b, int& R, int& C) { const int st = b / 1024, sb = b % 1024, swz = sb ^ (((sb >> 9) & 1) << 5); R = (st >> 1) * 16 + swz / 64; C = (st & 1) * 32 + (swz % 64) / 2; }
__host__ __device__ __forceinline__ int perm32(int rho) { const int n = rho >> 4, i = rho & 15; return 8 * (i >> 2) + 4 * n + (i & 3); }

struct Unit { int pm, pn; };
struct Gemm { const bf16_t* A; const bf16_t* Bt; int M, N, K, lda, ldb; };

struct StaticOrder {
    int nM, nN, nwg, G, c;
    __device__ void init(int M, int N, int G_, int c_) { nM = M / BM; nN = N / BM; nwg = nM * nN; G = G_; c = c_; }
    __device__ bool next(int i, Unit& u) const {
        const long L = (long)i * G + c; if (L >= nwg) return false;
        int wgid = (int)L; { const int q = nwg / NXCD, r = nwg % NXCD, xcd = wgid % NXCD, off = wgid / NXCD; wgid = (xcd < r ? xcd * (q + 1) : r * (q + 1) + (xcd - r) * q) + off; }
        const int nig = WGM * nN, gid = wgid / nig, fm = gid * WGM, gsz = (nM - fm) < WGM ? (nM - fm) : WGM;
        u.pm = fm + ((wgid % nig) % gsz); u.pn = (wgid % nig) / gsz; return true;
    }
};

struct Epi {
    int mode;
    bf16_t* obf; int ldo;
    int sigcol;
    bf16_t* kt;
    const bf16_t* gate; int ldg;
    __device__ __forceinline__ void operator()(const f32x4 (&acc)[2][2][4][2], const Unit& u, int wr, int wc, int fr, int fq) const {
        const int row0 = u.pm * BM + wr * 64 + fr, col0 = u.pn * BM + wc * 32 + 8 * fq;
        if (mode == 2) {
#pragma unroll
            for (int ai = 0; ai < 2; ++ai) {
                u32x4 GB[4][2];
#pragma unroll
                for (int m = 0; m < 4; ++m)
#pragma unroll
                    for (int bj = 0; bj < 2; ++bj) GB[m][bj] = *(const u32x4*)(gate + (size_t)(row0 + ai * HALF + m * 16) * ldg + col0 + bj * HALF + 2048);
                __builtin_amdgcn_sched_barrier(0);
#pragma unroll
                for (int m = 0; m < 4; ++m)
#pragma unroll
                    for (int bj = 0; bj < 2; ++bj) {
                        const u32x4 g = GB[m][bj]; f32x4 v0 = acc[ai][bj][m][0], v1 = acc[ai][bj][m][1];
                        v0[0] *= bflo(g.x); v0[1] *= bfhi(g.x); v0[2] *= bflo(g.y); v0[3] *= bfhi(g.y); v1[0] *= bflo(g.z); v1[1] *= bfhi(g.z); v1[2] *= bflo(g.w); v1[3] *= bfhi(g.w);
                        u32x4 w; w.x = cvt_pk_bf16(v0[0], v0[1]); w.y = cvt_pk_bf16(v0[2], v0[3]); w.z = cvt_pk_bf16(v1[0], v1[1]); w.w = cvt_pk_bf16(v1[2], v1[3]);
                        *(u32x4*)(obf + (size_t)(row0 + ai * HALF + m * 16) * ldo + col0 + bj * HALF) = w;
                    }
                __builtin_amdgcn_sched_barrier(0);
            }
            return;
        }
        if ((mode == 0) && (u.pn * BM >= sigcol)) {
            const int c0 = sigcol + (u.pn - sigcol / BM) * HALF + wc * 32 + 8 * fq;
#pragma unroll
            for (int ai = 0; ai < 2; ++ai)
#pragma unroll
                for (int m = 0; m < 4; ++m) {
                    const size_t row = (size_t)(row0 + ai * HALF + m * 16);
                    float rr[8], sb[8];
#pragma unroll
                    for (int e = 0; e < 8; ++e) { const float ga = acc[ai][0][m][e >> 2][e & 3], gb = acc[ai][1][m][e >> 2][e & 3];
                        const float eb = 1.0f + __expf(-gb); sb[e] = __builtin_amdgcn_rcpf(eb); rr[e] = eb * __builtin_amdgcn_rcpf(1.0f + __expf(-ga)); }
                    u32x4 w; w.x = cvt_pk_bf16(rr[0], rr[1]); w.y = cvt_pk_bf16(rr[2], rr[3]); w.z = cvt_pk_bf16(rr[4], rr[5]); w.w = cvt_pk_bf16(rr[6], rr[7]);
                    *(u32x4*)(obf + row * ldo + c0) = w;
                    w.x = cvt_pk_bf16(sb[0], sb[1]); w.y = cvt_pk_bf16(sb[2], sb[3]); w.z = cvt_pk_bf16(sb[4], sb[5]); w.w = cvt_pk_bf16(sb[6], sb[7]);
                    *(u32x4*)(obf + row * ldo + c0 + 2048) = w;
                }
            return;
        }
        const bool sg = false;
        const bool ktile = (mode == 0) && (kt != nullptr) && (u.pn >= 4) && (u.pn < 8);
#pragma unroll
        for (int ai = 0; ai < 2; ++ai)
#pragma unroll
            for (int m = 0; m < 4; ++m) {
                const size_t row = (size_t)(row0 + ai * HALF + m * 16);
#pragma unroll
                for (int bj = 0; bj < 2; ++bj) {
                    const int col = col0 + bj * HALF;
                    f32x4 v0 = acc[ai][bj][m][0], v1 = acc[ai][bj][m][1];
                    if (sg) {
#pragma unroll
                        for (int e = 0; e < 4; ++e) { v0[e] = sigmoidf_(v0[e]); v1[e] = sigmoidf_(v1[e]); }
                    }
                    u32x4 w; w.x = cvt_pk_bf16(v0[0], v0[1]); w.y = cvt_pk_bf16(v0[2], v0[3]); w.z = cvt_pk_bf16(v1[0], v1[1]); w.w = cvt_pk_bf16(v1[2], v1[3]);
                    if (ktile) __builtin_nontemporal_store(w, (u32x4*)(kt + (((row >> 6) * 8 + (size_t)((u.pn - 4) * 2 + bj)) * 64 + (row & 63)) * 128 + (wc * 32 + 8 * fq)));
                    else if (mode == 0) __builtin_nontemporal_store(w, (u32x4*)(obf + row * ldo + col));
                    else __builtin_nontemporal_store(w, (u32x4*)(obf + ((size_t)(col >> 6) * 2048 + row) * 64 + (col & 63)));
                }
            }
    }
    __device__ __forceinline__ void mid(f32x4 (&acc)[2][2][4][2], const Unit& u, int wr, int wc, int fr, int fq) const {
        int row0 = u.pm * BM + wr * 64 + fr, col0 = u.pn * BM + wc * 32 + 8 * fq;
        asm volatile("" : "+v"(row0), "+v"(col0));
        u32x4 RT[2][4][2];
#pragma unroll
        for (int ai = 0; ai < 2; ++ai)
#pragma unroll
            for (int m = 0; m < 4; ++m)
#pragma unroll
                for (int bj = 0; bj < 2; ++bj) RT[ai][m][bj] = *(const u32x4*)(gate + (size_t)(row0 + ai * HALF + m * 16) * ldg + col0 + bj * HALF);
        __builtin_amdgcn_sched_barrier(0);
#pragma unroll
        for (int ai = 0; ai < 2; ++ai)
#pragma unroll
            for (int m = 0; m < 4; ++m)
#pragma unroll
                for (int bj = 0; bj < 2; ++bj) {
                    const unsigned rw[4] = {RT[ai][m][bj].x, RT[ai][m][bj].y, RT[ai][m][bj].z, RT[ai][m][bj].w};
#pragma unroll
                    for (int i = 0; i < 4; ++i) { acc[ai][bj][m][i >> 1][(i & 1) * 2] *= bflo(rw[i]); acc[ai][bj][m][i >> 1][(i & 1) * 2 + 1] *= bfhi(rw[i]); }
                }
        __builtin_amdgcn_sched_barrier(0);
    }
};

__device__ __forceinline__ void gemm_phase(LAS unsigned char* lds, const Gemm g, const StaticOrder& S, const Epi& E, const int tid) {
    const int wid = __builtin_amdgcn_readfirstlane(tid >> 6), lane = tid & 63, wr = wid >> 2, wc = wid & 3, fr = lane & 15, fq = lane >> 4;
    const int K = g.K, nt = K / BK;
    unsigned voffA[2], voffB[2];
#pragma unroll
    for (int i = 0; i < 2; ++i) { int R, C; stage_rc(tid * 16 + i * 8192, R, C); const int Rb = (R & ~31) + perm32(R & 31);
        voffA[i] = (unsigned)(R * g.lda + C) * 2u; voffB[i] = (unsigned)(Rb * g.ldb + C) * 2u; }
    const size_t kstep = (size_t)(BK * 2);
    const size_t hstepA = (size_t)HALF * g.lda * 2, hstepB = (size_t)HALF * g.ldb * 2;
    const size_t tstepA = 2 * hstepA, tstepB = 2 * hstepB;
    const unsigned ldsw = (unsigned)wid * 1024u;
    const int aoff = lds_byte(wr * 64 + fr, fq * 8), boff = lds_byte(wc * 32 + fr, fq * 8);
#define PG8_SA(b, h) (((b) * 2 + (h)) * HTB)
#define PG8_SB(b, h) ((4 + (b) * 2 + (h)) * HTB)
#define PG8_STAGE(bufoff, gbase, voff) do { _Pragma("unroll") for (int _i = 0; _i < 2; ++_i) \
        __builtin_amdgcn_global_load_lds((const unsigned*)((const char*)(gbase) + (voff)[_i]), (LAS unsigned*)(lds + (bufoff) + ldsw + _i * 8192), 16, 0, 0); } while (0)
#define PG8_LDA(dst, b, h) do { _Pragma("unroll") for (int m = 0; m < 4; ++m) _Pragma("unroll") for (int k = 0; k < 2; ++k) dst[m][k] = *(const LAS bf16x8*)(lds + PG8_SA(b, h) + aoff + m * 2048 + k * 1024); } while (0)
#define PG8_LDB(dst, b, h) do { _Pragma("unroll") for (int n = 0; n < 2; ++n) _Pragma("unroll") for (int k = 0; k < 2; ++k) dst[n][k] = *(const LAS bf16x8*)(lds + PG8_SB(b, h) + boff + n * 2048 + k * 1024); } while (0)
#define PG8_MMA(ai, bj, At, Bt) do { __builtin_amdgcn_s_setprio(1); _Pragma("unroll") for (int m = 0; m < 4; ++m) _Pragma("unroll") for (int n = 0; n < 2; ++n) _Pragma("unroll") for (int k = 0; k < 2; ++k) \
        acc[ai][bj][m][n] = __builtin_amdgcn_mfma_f32_16x16x32_bf16(Bt[n][k], At[m][k], acc[ai][bj][m][n], 0, 0, 0); __builtin_amdgcn_s_setprio(0); } while (0)
#define PG8_WAIT_V(n) asm volatile("s_waitcnt vmcnt(" #n ")" ::: "memory")
#define PG8_WAIT_L(n) asm volatile("s_waitcnt lgkmcnt(" #n ")" ::: "memory")
#define PG8_BAR __builtin_amdgcn_s_barrier()
#define PG8_SCHED __builtin_amdgcn_sched_barrier(0)
    Unit cur, nxt; int ui = 0;
    if (!S.next(0, cur)) return;
    f32x4 acc[2][2][4][2];
#pragma unroll
    for (int a = 0; a < 2; ++a)
#pragma unroll
        for (int b = 0; b < 2; ++b)
#pragma unroll
            for (int m = 0; m < 4; ++m)
#pragma unroll
                for (int n = 0; n < 2; ++n) acc[a][b][m][n] = (f32x4){0.f, 0.f, 0.f, 0.f};
    bf16x8 At[4][2], B0[2][2], B1[2][2];
    const char* cA = (const char*)g.A + (size_t)cur.pm * tstepA; const char* cB = (const char*)g.Bt + (size_t)cur.pn * tstepB;
    PG8_STAGE(PG8_SB(0, 0), cB, voffB); PG8_STAGE(PG8_SB(0, 1), cB + hstepB, voffB); PG8_STAGE(PG8_SA(0, 0), cA, voffA); PG8_STAGE(PG8_SA(0, 1), cA + hstepA, voffA);
    if (wr == 1) PG8_BAR;
    PG8_WAIT_V(2); PG8_BAR;
    PG8_STAGE(PG8_SB(1, 0), cB + kstep, voffB); PG8_STAGE(PG8_SA(1, 0), cA + kstep, voffA); PG8_STAGE(PG8_SB(1, 1), cB + hstepB + kstep, voffB);
    PG8_WAIT_V(6); PG8_BAR;
    for (;;) {
        const bool has_next = S.next(ui + 1, nxt);
        const char* nA = has_next ? (const char*)g.A + (size_t)nxt.pm * tstepA : cA; const char* nB = has_next ? (const char*)g.Bt + (size_t)nxt.pn * tstepB : cB;
        for (int t = 0; t < nt; t += 2) {
            if (E.mode == 2 && t == (nt >> 1)) E.mid(acc, cur, wr, wc, fr, fq);
            const bool last = (t == nt - 2);
            const char* a1 = cA + (size_t)(t + 1) * kstep;
            const char* a2 = last ? nA : cA + (size_t)(t + 2) * kstep; const char* b2 = last ? nB : cB + (size_t)(t + 2) * kstep;
            const char* a3 = a2 + kstep; const char* b3 = b2 + kstep;
            PG8_LDB(B0, 0, 0); PG8_LDB(B1, 0, 1); PG8_SCHED; PG8_LDA(At, 0, 0); PG8_STAGE(PG8_SA(1, 1), a1 + hstepA, voffA);
            PG8_WAIT_V(8); PG8_WAIT_L(0); PG8_BAR; PG8_MMA(0, 0, At, B0); PG8_MMA(0, 1, At, B1); PG8_BAR; PG8_SCHED;
            PG8_LDA(At, 0, 1); PG8_STAGE(PG8_SB(0, 0), b2, voffB); PG8_STAGE(PG8_SB(0, 1), b2 + hstepB, voffB); PG8_STAGE(PG8_SA(0, 0), a2, voffA);
            PG8_WAIT_V(8); PG8_WAIT_L(0); PG8_BAR; PG8_MMA(1, 0, At, B0); PG8_MMA(1, 1, At, B1); PG8_BAR; PG8_SCHED;
            PG8_LDB(B0, 1, 0); PG8_LDB(B1, 1, 1); PG8_SCHED; PG8_LDA(At, 1, 0); PG8_STAGE(PG8_SA(0, 1), a2 + hstepA, voffA);
            PG8_WAIT_V(8); PG8_WAIT_L(0); PG8_BAR; PG8_MMA(0, 0, At, B0); PG8_MMA(0, 1, At, B1); PG8_BAR; PG8_SCHED;
            PG8_LDA(At, 1, 1); PG8_STAGE(PG8_SB(1, 0), b3, voffB); PG8_STAGE(PG8_SB(1, 1), b3 + hstepB, voffB); PG8_STAGE(PG8_SA(1, 0), a3, voffA);
            PG8_WAIT_V(8); PG8_WAIT_L(0); PG8_BAR; PG8_MMA(1, 0, At, B0); PG8_MMA(1, 1, At, B1); PG8_BAR; PG8_SCHED;
        }
        if (wr == 0) PG8_BAR;
        E(acc, cur, wr, wc, fr, fq);
#ifdef EPI2
        __builtin_amdgcn_sched_barrier(0); E(acc, cur, wr, wc, fr, fq);
#endif
        if (!has_next) break;
#pragma unroll
        for (int a = 0; a < 2; ++a)
#pragma unroll
            for (int b = 0; b < 2; ++b)
#pragma unroll
                for (int m = 0; m < 4; ++m)
#pragma unroll
                    for (int n = 0; n < 2; ++n) acc[a][b][m][n] = (f32x4){0.f, 0.f, 0.f, 0.f};
        cur = nxt; cA = nA; cB = nB; ++ui;
        if (wr == 1) PG8_BAR;
    }
    PG8_WAIT_V(0);
    PG8_BAR;
#undef PG8_SA
#undef PG8_SB
#undef PG8_STAGE
#undef PG8_LDA
#undef PG8_LDB
#undef PG8_MMA
#undef PG8_WAIT_V
#undef PG8_WAIT_L
#undef PG8_BAR
#undef PG8_SCHED
}
}

__device__ __forceinline__ void convert_tile(const float* W, bf16_t* Wt, int K, int N, int k0, int n0, int orow0, LAS bf16_t* tl, const int tid, int ldw, int kofs) {
    { const int kk = tid >> 4, n4 = (tid & 15) * 4;
#pragma unroll
      for (int h = 0; h < 2; ++h) { const int k = kk + 32 * h; const f32x4 v = *(const f32x4*)(W + (size_t)(k0 + k) * N + n0 + n4);
#pragma unroll
          for (int e = 0; e < 4; ++e) tl[(n4 + e) * 72 + k] = (bf16_t)f2bf(v[e]); } }
    __syncthreads();
    { const int n = tid >> 3, ks = (tid & 7) * 8; const u32x4 w = *(const LAS u32x4*)(tl + n * 72 + ks);
      *(u32x4*)(Wt + (size_t)(orow0 + n) * ldw + kofs + k0 + ks) = w; }
    __syncthreads();
}
__device__ __forceinline__ int win_row(int n0) {
    const int seg = n0 >> 10, r = n0 & 1023;
    switch (seg) { case 0: return r; case 1: return 1024 + r; case 2: return 9216 + r; case 3: return 2048 + r; case 4: return 3072 + r; case 5: return 10240 + r; case 6: return 4096 + r;
                   case 7: case 8: { const int c = n0 - 7168; return 5120 + (c >> 7) * 256 + (c & 127); }
                   default: { const int c = n0 - 9216; return 5120 + (c >> 7) * 256 + 128 + (c & 127); } }
}

__device__ __forceinline__ void rms_rows(const float* x, const float* g, bf16_t* H, const int tid) {
    const int wid = tid >> 6, lane = tid & 63, step = gridDim.x * 8;
    int row = blockIdx.x * 8 + wid;
    f32x4 v[8], vn[8], gg[8];
#pragma unroll
    for (int i = 0; i < 8; ++i) gg[i] = *(const f32x4*)(g + i * 256 + lane * 4);
    if (row < NTOK) {
#pragma unroll
        for (int i = 0; i < 8; ++i) v[i] = *(const f32x4*)(x + (size_t)row * DM + i * 256 + lane * 4); }
    for (; row < NTOK; row += step) {
        const int nrow = row + step;
        if (nrow < NTOK) {
#pragma unroll
            for (int i = 0; i < 8; ++i) vn[i] = *(const f32x4*)(x + (size_t)nrow * DM + i * 256 + lane * 4); }
        float ss = 0.f;
#pragma unroll
        for (int i = 0; i < 8; ++i) ss += v[i][0] * v[i][0] + v[i][1] * v[i][1] + v[i][2] * v[i][2] + v[i][3] * v[i][3];
#pragma unroll
        for (int o = 32; o > 0; o >>= 1) ss += __shfl_xor(ss, o);
        const float rstd = __builtin_amdgcn_rsqf(ss * (1.0f / DM) + 1e-6f);
#pragma unroll
        for (int i = 0; i < 8; ++i) {
            u32x2 w; w.x = cvt_pk_bf16(v[i][0] * rstd * gg[i][0], v[i][1] * rstd * gg[i][1]); w.y = cvt_pk_bf16(v[i][2] * rstd * gg[i][2], v[i][3] * rstd * gg[i][3]);
            *(u32x2*)(H + (size_t)row * DM + i * 256 + lane * 4) = w; }
#pragma unroll
        for (int i = 0; i < 8; ++i) v[i] = vn[i];
    }
}

__device__ __forceinline__ void post_rows(const float* xin, const bf16_t* OUT, const float* pg, float* out, const float* ng, bf16_t* H, const int tid) {
    const int wid = tid >> 6, lane = tid & 63, step = gridDim.x * 8;
    int row = blockIdx.x * 8 + wid;
    u32x2 ow[8], own[8]; f32x4 xw[8], xwn[8], pgv[8], ngv[8];
#pragma unroll
    for (int i = 0; i < 8; ++i) { pgv[i] = *(const f32x4*)(pg + i * 256 + lane * 4); ngv[i] = ng ? *(const f32x4*)(ng + i * 256 + lane * 4) : (f32x4){0.f, 0.f, 0.f, 0.f}; }
    if (row < NTOK) {
#pragma unroll
        for (int i = 0; i < 8; ++i) { ow[i] = *(const u32x2*)(OUT + (size_t)row * DM + i * 256 + lane * 4); xw[i] = *(const f32x4*)(xin + (size_t)row * DM + i * 256 + lane * 4); } }
    for (; row < NTOK; row += step) {
        const int nrow = row + step;
        if (nrow < NTOK) {
#pragma unroll
            for (int i = 0; i < 8; ++i) { own[i] = *(const u32x2*)(OUT + (size_t)nrow * DM + i * 256 + lane * 4); xwn[i] = *(const f32x4*)(xin + (size_t)nrow * DM + i * 256 + lane * 4); } }
        f32x4 o[8]; float ss = 0.f;
#pragma unroll
        for (int i = 0; i < 8; ++i) { const u32x2 w = ow[i];
            o[i][0] = bflo(w.x); o[i][1] = bfhi(w.x); o[i][2] = bflo(w.y); o[i][3] = bfhi(w.y); ss += o[i][0] * o[i][0] + o[i][1] * o[i][1] + o[i][2] * o[i][2] + o[i][3] * o[i][3]; }
#pragma unroll
        for (int s = 32; s > 0; s >>= 1) ss += __shfl_xor(ss, s);
        const float rstd = __builtin_amdgcn_rsqf(ss * (1.0f / DM) + 1e-6f);
        float s2 = 0.f;
#pragma unroll
        for (int i = 0; i < 8; ++i) { const f32x4 gg = pgv[i]; const f32x4 xv = xw[i];
            f32x4 r; r[0] = xv[0] + o[i][0] * rstd * gg[0]; r[1] = xv[1] + o[i][1] * rstd * gg[1]; r[2] = xv[2] + o[i][2] * rstd * gg[2]; r[3] = xv[3] + o[i][3] * rstd * gg[3];
            *(f32x4*)(out + (size_t)row * DM + i * 256 + lane * 4) = r; o[i] = r; s2 += r[0] * r[0] + r[1] * r[1] + r[2] * r[2] + r[3] * r[3]; }
        if (ng) {
#pragma unroll
            for (int s = 32; s > 0; s >>= 1) s2 += __shfl_xor(s2, s);
            const float rs2 = __builtin_amdgcn_rsqf(s2 * (1.0f / DM) + 1e-6f);
#pragma unroll
            for (int i = 0; i < 8; ++i) { const f32x4 gg = ngv[i];
                u32x2 w; w.x = cvt_pk_bf16(o[i][0] * rs2 * gg[0], o[i][1] * rs2 * gg[1]); w.y = cvt_pk_bf16(o[i][2] * rs2 * gg[2], o[i][3] * rs2 * gg[3]);
                *(u32x2*)(H + (size_t)row * DM + i * 256 + lane * 4) = w; }
        }
#pragma unroll
        for (int i = 0; i < 8; ++i) { ow[i] = own[i]; xw[i] = xwn[i]; }
    }
}

constexpr int NA_SLOT = 18432;
constexpr int NA_RPB_OFF = 3 * NA_SLOT;
#define NA_BAR() do { asm volatile("s_waitcnt lgkmcnt(0)" ::: "memory"); __builtin_amdgcn_s_barrier(); asm volatile("" ::: "memory"); } while (0)

struct NaUnit { int b, r0, head, rsA, delta; };
__device__ __forceinline__ NaUnit na_decode(int u) {
    NaUnit n; const int cc = u & 255, idx = cc >> 3; n.head = u >> 8; n.b = idx >> 4; n.r0 = 2 * ((cc & 7) * 16 + (idx & 15));
    n.rsA = min(max(n.r0 - 4, 0), 248); n.delta = min(max(n.r0 - 3, 0), 248) - n.rsA; return n; }

template <int I> __device__ __forceinline__ void na_issue(u32x4 (&R)[2], const bf16_t* KT, const bf16_t* VT, const NaUnit& n, const int tid) {
    if constexpr (I < 9) {
        const int row = min(n.rsA + I, 255);
        const bf16_t* base = KT + ((size_t)((n.b * 256 + row) * 8 + n.head)) * 8192 + tid * 8;
        R[0] = *(const u32x4*)base; R[1] = *(const u32x4*)(base + 4096);
    } else {
        const int row = min(n.rsA + (I - 9), 255);
        const bf16_t* base = VT + ((size_t)((n.b * 256 + row) * 2048 + n.head * 128)) * 64 + tid * 8;
        R[0] = *(const u32x4*)base; R[1] = *(const u32x4*)(base + 4096);
    }
}
template <int I> __device__ __forceinline__ void na_write(const u32x4 (&R)[2], LAS unsigned char* ring, const int tid) {
    LAS unsigned char* slot = ring + (I % 3) * NA_SLOT;
    if constexpr (I < 9) { LAS unsigned char* d = slot + (tid >> 4) * 288 + (tid & 15) * 16; *(LAS u32x4*)d = R[0]; *(LAS u32x4*)(d + 32 * 288) = R[1]; }
    else { LAS unsigned char* d = slot + (tid >> 3) * 144 + (tid & 7) * 16; *(LAS u32x4*)d = R[0]; *(LAS u32x4*)(d + 64 * 144) = R[1]; }
}

struct NaState { f32x4 s[8][2]; bf16x8 pf[8]; f32x4 o[8]; bf16x8 qf[4]; u32x2 z[8]; float inv; int idx[4]; bool sel[4]; unsigned m01, m23; };

template <int T> __device__ __forceinline__ void na_kstep(NaState& st, const LAS unsigned char* ring, int shift, int kc0, int fr, int fq) {
    const LAS unsigned char* base = ring + ((T + shift) % 3) * NA_SLOT + (kc0 + fr) * 288 + fq * 16;
    bf16x8 kf[2][4];
#pragma unroll
    for (int ct = 0; ct < 2; ++ct)
#pragma unroll
        for (int ks = 0; ks < 4; ++ks) kf[ct][ks] = *(const LAS bf16x8*)(base + ct * 16 * 288 + ks * 64);
    __builtin_amdgcn_sched_barrier(0);
    f32x4 a0 = {0.f, 0.f, 0.f, 0.f}, a1 = {0.f, 0.f, 0.f, 0.f};
#pragma unroll
    for (int ks = 0; ks < 4; ++ks) { a0 = __builtin_amdgcn_mfma_f32_16x16x32_bf16(kf[0][ks], st.qf[ks], a0, 0, 0, 0); a1 = __builtin_amdgcn_mfma_f32_16x16x32_bf16(kf[1][ks], st.qf[ks], a1, 0, 0, 0); }
    st.s[T][0] = a0; st.s[T][1] = a1;
}
template <int T> __device__ __forceinline__ void na_vstep(NaState& st, const LAS unsigned char* ring, int shift, int kc0, int fr, int fq) {
    const LAS unsigned char* vp = ring + ((9 + T + shift) % 3) * NA_SLOT + fr * 144 + (kc0 + 4 * fq) * 2;
    unsigned vph = (unsigned)(size_t)vp + 32u; asm volatile("" : "+v"(vph));
    const LAS unsigned char* vp2 = (const LAS unsigned char*)(size_t)vph;
    u32x2 lo[8], hi[8];
#pragma unroll
    for (int dt = 0; dt < 8; ++dt) { lo[dt] = *(const LAS u32x2*)(vp + dt * 16 * 144); hi[dt] = *(const LAS u32x2*)(vp2 + dt * 16 * 144); }
    __builtin_amdgcn_sched_barrier(0);
#pragma unroll
    for (int dt = 0; dt < 8; ++dt) {
        u32x4 w; w.x = lo[dt].x; w.y = lo[dt].y; w.z = hi[dt].x; w.w = hi[dt].y;
        st.o[dt] = __builtin_amdgcn_mfma_f32_16x16x32_bf16(__builtin_bit_cast(bf16x8, w), st.pf[T], st.o[dt], 0, 0, 0);
    }
}
__device__ __forceinline__ void na_softmax(NaState& st, const LAS float* rp, int head, int drow0) {
    const float scale2 = 0.08838834764831845f * 1.4426950408889634f;
    float mx = -1e30f;
#pragma unroll
    for (int ki = 0; ki < 8; ++ki) {
        const LAS float* row = rp + (head * 15 + drow0 + ki) * 32;
#pragma unroll
        for (int j = 0; j < 4; ++j) { const float sv = st.sel[j] ? st.s[ki][0][j] : st.s[ki][1][j]; const float v = __builtin_fmaf(sv, scale2, row[st.idx[j]]); st.s[ki][0][j] = v; mx = fmaxf(mx, v); }
    }
    mx = fmaxf(mx, __shfl_xor(mx, 16)); mx = fmaxf(mx, __shfl_xor(mx, 32));
    float sum = 0.f;
    const unsigned m01 = st.m01, m23 = st.m23;
#pragma unroll
    for (int ki = 0; ki < 8; ++ki) {
        float e[4];
#pragma unroll
        for (int j = 0; j < 4; ++j) { e[j] = __builtin_amdgcn_exp2f(st.s[ki][0][j] - mx); sum += e[j]; }
        const unsigned p01 = cvt_pk_bf16(e[0], e[1]), p23 = cvt_pk_bf16(e[2], e[3]);
        u32x4 w; w.x = p01 & m01; w.y = p23 & m23; w.z = p01 & ~m01; w.w = p23 & ~m23;
        st.pf[ki] = __builtin_bit_cast(bf16x8, w);
    }
    sum += __shfl_xor(sum, 16); sum += __shfl_xor(sum, 32);
    st.inv = 1.0f / sum;
#pragma unroll
    for (int dt = 0; dt < 8; ++dt) st.o[dt] = (f32x4){0.f, 0.f, 0.f, 0.f};
}

template <int skip> __device__ __forceinline__ void na_phase(const Params& p, int layer, LAS unsigned char* lds, const int tid) {
    LAS float* rp = (LAS float*)(lds + NA_RPB_OFF);
    for (int i = tid; i < 8 * 15 * 32; i += 512) { const int rw = i >> 5, cl = i & 31; rp[i] = (cl < 31) ? p.rpb[layer * RPB_N + rw * 31 + cl] * 1.4426950408889634f : -1e30f; }
    const bf16_t* PROJ = (const bf16_t*)(p.ws + WS_PROJ); const bf16_t* VT = (const bf16_t*)(p.ws + WS_VT); bf16_t* Y = (bf16_t*)(p.ws + WS_H); const bf16_t* KT = (const bf16_t*)(p.ws + WS_KT);
    const int wid = __builtin_amdgcn_readfirstlane(tid >> 6), lane = tid & 63, fr = lane & 15, fq = lane >> 4, ri = wid >> 2, qb = wid & 3;
    const int kc0 = (qb == 0) ? 0 : (qb == 1) ? 8 : (qb == 2) ? 24 : 32, qcol = 16 * qb + fr;
    const int G = (int)gridDim.x, c = (int)blockIdx.x;
    if (c >= 2048) { __syncthreads(); return; }
    LAS unsigned char* ring = lds;
    NaState st; u32x4 R0[2], R1[2], R2[2], R3[2], R4[2], R5[2];
    { const int cs = min(max(qcol - 8, 0), 48); unsigned m01 = 0u, m23 = 0u;
#pragma unroll
      for (int j = 0; j < 4; ++j) { const int k0 = kc0 + 4 * fq + j; const bool v0 = (k0 >= cs) && (k0 < cs + 16);
          st.sel[j] = v0; st.idx[j] = (v0 ? k0 : k0 + 16) - qcol + 15;
          if (v0) { if (j == 0) m01 |= 0xffffu; if (j == 1) m01 |= 0xffff0000u; if (j == 2) m23 |= 0xffffu; if (j == 3) m23 |= 0xffff0000u; } }
      st.m01 = m01; st.m23 = m23; }
    NaUnit cur = na_decode(c);
    na_issue<0>(R0, KT, VT, cur, tid); na_issue<1>(R1, KT, VT, cur, tid); na_issue<2>(R2, KT, VT, cur, tid);
    na_issue<3>(R3, KT, VT, cur, tid); na_issue<4>(R4, KT, VT, cur, tid); na_issue<5>(R5, KT, VT, cur, tid);
    { const size_t qtok = (size_t)(cur.b * SEQ + (cur.r0 + ri) * 64 + qcol);
#pragma unroll
      for (int ks = 0; ks < 4; ++ks) st.qf[ks] = *(const bf16x8*)(PROJ + qtok * NP + Q_OFF + cur.head * 128 + ks * 32 + fq * 8); }
    for (int u = c; u < 2048; u += G) {
        const bool has_next = (u + G) < 2048;
        const NaUnit nxt = has_next ? na_decode(u + G) : cur;
        const int my_r = cur.r0 + ri, shift = ri ? cur.delta : 0, head = cur.head;
        const size_t qtok = (size_t)(cur.b * SEQ + my_r * 64 + qcol);
#define NA_PUT(I, RR, NU, NI) do { if constexpr (!(skip & 8)) { na_write<I>(RR, ring, tid); na_issue<NI>(RR, KT, VT, NU, tid); } } while (0)
        NA_BAR();
        NA_PUT(0, R0, cur, 6); NA_PUT(1, R1, cur, 7);   NA_BAR(); if constexpr (!(skip & 1)) na_kstep<0>(st, ring, shift, kc0, fr, fq);
        NA_PUT(2, R2, cur, 8);                          NA_BAR(); if constexpr (!(skip & 1)) na_kstep<1>(st, ring, shift, kc0, fr, fq);
        NA_PUT(3, R3, cur, 9);                          NA_BAR(); if constexpr (!(skip & 1)) na_kstep<2>(st, ring, shift, kc0, fr, fq);
        NA_PUT(4, R4, cur, 10);                          NA_BAR(); if constexpr (!(skip & 1)) na_kstep<3>(st, ring, shift, kc0, fr, fq);
        NA_PUT(5, R5, cur, 11);                          NA_BAR(); if constexpr (!(skip & 1)) na_kstep<4>(st, ring, shift, kc0, fr, fq);
        NA_PUT(6, R0, cur, 12);                          NA_BAR(); if constexpr (!(skip & 1)) na_kstep<5>(st, ring, shift, kc0, fr, fq);
        NA_PUT(7, R1, cur, 13);                         NA_BAR(); if constexpr (!(skip & 1)) na_kstep<6>(st, ring, shift, kc0, fr, fq);
        NA_PUT(8, R2, cur, 14);                         NA_BAR(); if constexpr (!(skip & 1)) na_kstep<7>(st, ring, shift, kc0, fr, fq);
        if constexpr (!(skip & 2)) na_softmax(st, rp, head, (cur.rsA + shift) - my_r + 7);
        if constexpr (!(skip & 4)) {
#pragma unroll
        for (int dt = 0; dt < 8; ++dt) st.z[dt] = *(const u32x2*)(PROJ + qtok * NP + ZA_OFF + head * 128 + dt * 16 + 4 * fq); }
        NA_BAR();
        NA_PUT(9, R3, cur, 15); NA_PUT(10, R4, cur, 16); NA_BAR(); if constexpr (!(skip & 1)) na_vstep<0>(st, ring, shift, kc0, fr, fq);
        NA_PUT(11, R5, cur, 17);                         NA_BAR(); if constexpr (!(skip & 1)) na_vstep<1>(st, ring, shift, kc0, fr, fq);
        NA_PUT(12, R0, nxt, 0);                         NA_BAR(); if constexpr (!(skip & 1)) na_vstep<2>(st, ring, shift, kc0, fr, fq);
        NA_PUT(13, R1, nxt, 1);                         NA_BAR(); if constexpr (!(skip & 1)) na_vstep<3>(st, ring, shift, kc0, fr, fq);
        NA_PUT(14, R2, nxt, 2);                         NA_BAR(); if constexpr (!(skip & 1)) na_vstep<4>(st, ring, shift, kc0, fr, fq);
        { const size_t nq = (size_t)(nxt.b * SEQ + (nxt.r0 + ri) * 64 + qcol);
#pragma unroll
          for (int ks = 0; ks < 4; ++ks) st.qf[ks] = *(const bf16x8*)(PROJ + nq * NP + Q_OFF + nxt.head * 128 + ks * 32 + fq * 8); }
        NA_PUT(15, R3, nxt, 3);                          NA_BAR(); if constexpr (!(skip & 1)) na_vstep<5>(st, ring, shift, kc0, fr, fq);
        NA_PUT(16, R4, nxt, 4);                          NA_BAR(); if constexpr (!(skip & 1)) na_vstep<6>(st, ring, shift, kc0, fr, fq);
        NA_PUT(17, R5, nxt, 5);                          NA_BAR(); if constexpr (!(skip & 1)) na_vstep<7>(st, ring, shift, kc0, fr, fq);
#undef NA_PUT
        if constexpr (!(skip & 4))
#pragma unroll
        for (int dt = 0; dt < 8; ++dt) {
            const f32x4 o = st.o[dt]; const u32x2 z = st.z[dt]; const float inv = st.inv;
            u32x2 y; y.x = cvt_pk_bf16(o[0] * inv * siluf_(bflo(z.x)), o[1] * inv * siluf_(bfhi(z.x))); y.y = cvt_pk_bf16(o[2] * inv * siluf_(bflo(z.y)), o[3] * inv * siluf_(bfhi(z.y)));
            *(u32x2*)(Y + qtok * DM + head * 128 + dt * 16 + 4 * fq) = y;
        }
        cur = nxt;
    }
    __syncthreads();
}

struct SgPre { u32x4 vs[4]; u32x2 u[8], z[8]; float bb[8]; float lg, lb; };
__device__ __forceinline__ void sg_fetch(SgPre& P, u32x4 (&WR)[4], const char* PROJ, const char* VT, const char* Wsb, const float* lng, const float* lnb, const float* bs,
                                         int chunk, int g, int wid, int fr, int fq, int tid) {
    const int ch = g * 128 + 16 * wid + fr, c4 = g * 128 + 16 * wid + 4 * fq;
    const unsigned woff = (unsigned)g * 32768u + (unsigned)tid * 16u;
#pragma unroll
    for (int i = 0; i < 4; ++i) WR[i] = *(const u32x4*)(Wsb + (size_t)(woff + 8192u * i));
#pragma unroll
    for (int ks = 0; ks < 4; ++ks) { const int t0 = 32 * ks + 8 * fq; const unsigned vo = ((unsigned)((chunk * 2 + (t0 >> 6)) * 2048 + 1024 + ch) * 64u + (unsigned)(t0 & 63)) * 2u; P.vs[ks] = *(const u32x4*)(VT + (size_t)vo); }
    const unsigned uo = ((unsigned)(chunk * 128 + fr) * (unsigned)NP + (unsigned)(U_OFF + c4)) * 2u;
#pragma unroll
    for (int st = 0; st < 8; ++st) { const unsigned o = uo + (unsigned)st * (16u * NP * 2u);
        P.u[st] = *(const u32x2*)(PROJ + (size_t)o); P.z[st] = *(const u32x2*)(PROJ + (size_t)o + (ZB_OFF - U_OFF) * 2); P.bb[st] = bs[g * 128 + st * 16 + fr]; }
    P.lg = lng[ch]; P.lb = lnb[ch];
}
__device__ __forceinline__ void sg_group(const SgPre& P, const LAS unsigned char* wb, const LAS float* mu, const LAS float* rsd, char* Y, int tok0, int g, int wid, int fr, int fq) {
    const float lg = P.lg, lb = P.lb;
    bf16x8 af[4];
#pragma unroll
    for (int ks = 0; ks < 4; ++ks) {
        const int t0 = 32 * ks + 8 * fq; const u32x4 v = P.vs[ks];
        const f32x4 m0 = *(const LAS f32x4*)(mu + t0), m1 = *(const LAS f32x4*)(mu + t0 + 4), r0 = *(const LAS f32x4*)(rsd + t0), r1 = *(const LAS f32x4*)(rsd + t0 + 4);
        u32x4 w;
        w.x = cvt_pk_bf16((bflo(v.x) - m0[0]) * r0[0] * lg + lb, (bfhi(v.x) - m0[1]) * r0[1] * lg + lb);
        w.y = cvt_pk_bf16((bflo(v.y) - m0[2]) * r0[2] * lg + lb, (bfhi(v.y) - m0[3]) * r0[3] * lg + lb);
        w.z = cvt_pk_bf16((bflo(v.z) - m1[0]) * r1[0] * lg + lb, (bfhi(v.z) - m1[1]) * r1[1] * lg + lb);
        w.w = cvt_pk_bf16((bflo(v.w) - m1[2]) * r1[2] * lg + lb, (bfhi(v.w) - m1[3]) * r1[3] * lg + lb);
        af[ks] = __builtin_bit_cast(bf16x8, w);
    }
    const unsigned yo = ((unsigned)(tok0 + fr) * (unsigned)DM + (unsigned)(g * 128 + 16 * wid + 4 * fq)) * 2u;
#pragma unroll
    for (int st = 0; st < 8; ++st) {
        const LAS unsigned char* wp = wb + (st * 16 + fr) * 288 + fq * 16;
        f32x4 a = {0.f, 0.f, 0.f, 0.f};
#pragma unroll
        for (int ks = 0; ks < 4; ++ks) { const bf16x8 wf = *(const LAS bf16x8*)(wp + ks * 64); a = __builtin_amdgcn_mfma_f32_16x16x32_bf16(af[ks], wf, a, 0, 0, 0); }
        const float bb = P.bb[st]; const u32x2 uu = P.u[st], z = P.z[st];
        u32x2 y;
        y.x = cvt_pk_bf16(bflo(uu.x) * (a[0] + bb) * siluf_(bflo(z.x)), bfhi(uu.x) * (a[1] + bb) * siluf_(bfhi(z.x)));
        y.y = cvt_pk_bf16(bflo(uu.y) * (a[2] + bb) * siluf_(bflo(z.y)), bfhi(uu.y) * (a[3] + bb) * siluf_(bfhi(z.y)));
        *(u32x2*)(Y + (size_t)(yo + (unsigned)st * (16u * DM * 2u))) = y;
    }
}
__device__ __forceinline__ void sg_phase(const Params& p, int layer, LAS unsigned char* lds, const int tid) {
    LAS float* red = (LAS float*)(lds + 73728);
    LAS float* mu = (LAS float*)(lds + 73728 + 8192);
    LAS float* rsd = mu + 128;
    const char* PROJ = (const char*)(p.ws + WS_PROJ); const char* VT = (const char*)(p.ws + WS_VT); char* Y = (char*)(p.ws + WS_H) + 2048;
    const char* Wsb = (const char*)(p.ws + WS_W + layer * SZ_LAYER_W + OFF_SGW);
    const float* lng = p.ln_g + layer * 1024; const float* lnb = p.ln_b + layer * 1024; const float* bs = p.sg_b + layer * 1024;
    const int wid = __builtin_amdgcn_readfirstlane(tid >> 6), lane = tid & 63, fr = lane & 15, fq = lane >> 4;
    for (int chunk = blockIdx.x; chunk < 256; chunk += gridDim.x) {
        const int tok0 = chunk * 128;
        __syncthreads();
        SgPre P0, P1; u32x4 WR[4];
        sg_fetch(P0, WR, PROJ, VT, Wsb, lng, lnb, bs, chunk, 0, wid, fr, fq, tid);
        { const int tg = tid & 15; float s1[8], s2[8];
#pragma unroll
          for (int e = 0; e < 8; ++e) { s1[e] = 0.f; s2[e] = 0.f; }
          const unsigned vb = ((unsigned)((chunk * 2 + (tg >> 3)) * 2048 + 1024 + (tid >> 4)) * 64u + (unsigned)((tg & 7) * 8)) * 2u;
#pragma unroll 16
          for (int i = 0; i < 32; ++i) { const u32x4 v = *(const u32x4*)(VT + (size_t)(vb + (unsigned)i * 4096u));
              const unsigned w[4] = {v.x, v.y, v.z, v.w};
#pragma unroll
              for (int e = 0; e < 4; ++e) { const float f0 = bflo(w[e]), f1 = bfhi(w[e]); s1[2 * e] += f0; s1[2 * e + 1] += f1; s2[2 * e] += f0 * f0; s2[2 * e + 1] += f1 * f1; } }
#pragma unroll
          for (int e = 0; e < 8; ++e) { s1[e] += __shfl_xor(s1[e], 16); s1[e] += __shfl_xor(s1[e], 32); s2[e] += __shfl_xor(s2[e], 16); s2[e] += __shfl_xor(s2[e], 32); }
          if (lane < 16) {
#pragma unroll
              for (int e = 0; e < 8; ++e) { red[(wid * 128 + tg * 8 + e) * 2] = s1[e]; red[(wid * 128 + tg * 8 + e) * 2 + 1] = s2[e]; } } }
        NA_BAR();
        if (tid < 128) { float a = 0.f, q = 0.f;
#pragma unroll
            for (int pp = 0; pp < 8; ++pp) { a += red[(pp * 128 + tid) * 2]; q += red[(pp * 128 + tid) * 2 + 1]; }
            const float mean = a * (1.0f / 1024.f); const float var = fmaxf(q * (1.0f / 1024.f) - mean * mean, 0.f);
            mu[tid] = mean; rsd[tid] = __builtin_amdgcn_rsqf(var + 1e-5f); }
        NA_BAR();
#define SG_GROUP(G, B, PC, PN, MORE) do { \
            { LAS unsigned char* wd = lds + (B) * 36864 + (tid >> 4) * 288 + (tid & 15) * 16; \
              _Pragma("unroll") for (int i = 0; i < 4; ++i) *(LAS u32x4*)(wd + i * 32 * 288) = WR[i]; } \
            if (MORE) sg_fetch(PN, WR, PROJ, VT, Wsb, lng, lnb, bs, chunk, (G) + 1, wid, fr, fq, tid); \
            NA_BAR(); \
            sg_group(PC, lds + (B) * 36864, mu, rsd, Y, tok0, (G), wid, fr, fq); } while (0)
#pragma unroll 1
        for (int g2 = 0; g2 < 4; ++g2) { SG_GROUP(2 * g2, 0, P0, P1, true); SG_GROUP(2 * g2 + 1, 1, P1, P0, g2 < 3); }
#undef SG_GROUP
    }
}

struct CvtTile { const float* src; bf16_t* dst; int N, ldw; };
__device__ __forceinline__ CvtTile cvt_decode(const Params& p, int t) {
    constexpr int T_IN = 32 * 176, T_P = 16 * 32, T_LAYER = T_IN + 2 * T_P + 32 * 32;
    const int layer = t / T_LAYER; int r = t % T_LAYER;
    unsigned char* wl = p.ws + WS_W + layer * SZ_LAYER_W; CvtTile c;
    if (r < T_IN) { const int kt = r & 31, nt = r >> 5; c.N = NIN; c.ldw = DM; c.src = p.w_in + (size_t)layer * DM * NIN + (size_t)(kt * 64) * NIN + nt * 64; c.dst = (bf16_t*)(wl + OFF_WIN) + (size_t)win_row(nt * 64) * DM + kt * 64; }
    else if ((r -= T_IN) < T_P) { const int kt = r & 15, nt = r >> 4; c.N = DM; c.ldw = DM; c.src = p.w_pa + (size_t)layer * 1024 * DM + (size_t)(kt * 64) * DM + nt * 64; c.dst = (bf16_t*)(wl + OFF_WPA) + (size_t)(nt * 64) * DM + kt * 64; }
    else if ((r -= T_P) < T_P) { const int kt = r & 15, nt = r >> 4; c.N = DM; c.ldw = DM; c.src = p.w_pb + (size_t)layer * 1024 * DM + (size_t)(kt * 64) * DM + nt * 64; c.dst = (bf16_t*)(wl + OFF_WPA) + (size_t)(nt * 64) * DM + 1024 + kt * 64; }
    else { r -= T_P; const int kt = r & 31, nt = r >> 5; c.N = DM; c.ldw = DM; c.src = p.w_out + (size_t)layer * DM * DM + (size_t)(kt * 64) * DM + nt * 64; c.dst = (bf16_t*)(wl + OFF_WOUT) + (size_t)(nt * 64) * DM + kt * 64; }
    return c;
}
__device__ __forceinline__ void prologue(const Params& p, LAS unsigned char* lds, const int tid) {
    constexpr int T_TOTAL = DEPTH * (32 * 176 + 2 * 16 * 32 + 32 * 32);
    { const int kk = tid >> 4, n4 = (tid & 15) * 4, wn = tid >> 3, wks = (tid & 7) * 8;
      int t = blockIdx.x; f32x4 v0, v1; CvtTile cur;
      if (t < T_TOTAL) { cur = cvt_decode(p, t); v0 = *(const f32x4*)(cur.src + (size_t)kk * cur.N + n4); v1 = *(const f32x4*)(cur.src + (size_t)(kk + 32) * cur.N + n4); }
      for (int it = 0; t < T_TOTAL; t += gridDim.x, ++it) {
          LAS bf16_t* tl = (LAS bf16_t*)lds + (it & 1) * (64 * 72);
#pragma unroll
          for (int e = 0; e < 4; ++e) { tl[(n4 + e) * 72 + kk] = (bf16_t)f2bf(v0[e]); tl[(n4 + e) * 72 + kk + 32] = (bf16_t)f2bf(v1[e]); }
          const CvtTile me = cur;
          if (t + (int)gridDim.x < T_TOTAL) { cur = cvt_decode(p, t + gridDim.x); v0 = *(const f32x4*)(cur.src + (size_t)kk * cur.N + n4); v1 = *(const f32x4*)(cur.src + (size_t)(kk + 32) * cur.N + n4); }
          NA_BAR();
          const u32x4 w = *(const LAS u32x4*)(tl + wn * 72 + wks);
          *(u32x4*)(me.dst + (size_t)wn * me.ldw + wks) = w;
      }
      __syncthreads(); }
    for (int i = blockIdx.x * 512 + tid; i < DEPTH * 8 * 128 * 128 / 4; i += gridDim.x * 512) {
        const int layer = i / (8 * 128 * 128 / 4), e = i % (8 * 128 * 128 / 4);
        const f32x4 v = *(const f32x4*)(p.sg_w + (size_t)layer * 8 * 128 * 128 + e * 4);
        u32x2 w; w.x = cvt_pk_bf16(v[0], v[1]); w.y = cvt_pk_bf16(v[2], v[3]);
        *(u32x2*)((bf16_t*)(p.ws + WS_W + layer * SZ_LAYER_W + OFF_SGW) + e * 4) = w;
    }
    rms_rows(p.x, p.pre_g, (bf16_t*)(p.ws + WS_H), tid);
}

#define XB_TMO      128
#define XB_XCNT(j)  (256  + 64 * (j))
#define XB_XSUB(j)  (1280 + 64 * (j))
#define XB_XGEN(j)  (2304 + 64 * (j))
#define XB_TOP      3328
#define XB_TOPGEN   3392
#define XCD_BAR_WORDS 3456
#define XB_SPIN_CAP (1u << 22)
__device__ __forceinline__ unsigned xb_ld(unsigned* p)              { return __hip_atomic_load(p, __ATOMIC_RELAXED, __HIP_MEMORY_SCOPE_AGENT); }
__device__ __forceinline__ unsigned xb_add(unsigned* p, unsigned v) { return __hip_atomic_fetch_add(p, v, __ATOMIC_RELAXED, __HIP_MEMORY_SCOPE_AGENT); }
__device__ __forceinline__ unsigned xb_xcc_id() { return (unsigned)__builtin_amdgcn_s_getreg((3 << 11) | 20) & 0xFu; }
#define XB_SPIN(cond, bar) do { unsigned _sp = 0; while (cond) { __builtin_amdgcn_s_sleep(1); \
    if ((++_sp & 255u) == 0u) { if (xb_ld(&(bar)[XB_TMO])) break; if (_sp > XB_SPIN_CAP) { atomicAdd(&(bar)[XB_TMO], 1u); break; } } } } while (0)
__device__ __forceinline__ void xcd_barrier_complete(unsigned* bar, unsigned x, unsigned& nloc, unsigned& nx) {
    const unsigned G = gridDim.x * gridDim.y * gridDim.z;
    unsigned sum, cnt, mine, sp = 0u;
    for (;;) {
        sum = 0u; cnt = 0u; mine = 0u;
#pragma unroll
        for (unsigned j = 0; j < 16; ++j) { const unsigned c = xb_ld(&bar[XB_XCNT(j)]); sum += c; cnt += (c > 0u) ? 1u : 0u; mine = (j == x) ? c : mine; }
        if (sum == G) break;
        __builtin_amdgcn_s_sleep(1);
        if ((++sp & 255u) == 0u) { if (xb_ld(&bar[XB_TMO])) break; if (sp > XB_SPIN_CAP) { atomicAdd(&bar[XB_TMO], 1u); break; } }
    }
    nloc = mine > 0u ? mine : 1u; nx = cnt > 0u ? cnt : 1u;
}
__device__ __forceinline__ void xcd_barrier(unsigned* bar, volatile LAS unsigned* st) {
    asm volatile("s_waitcnt vmcnt(0)" ::: "memory");
    __syncthreads();
    if (threadIdx.x == 0) {
        const unsigned x = xb_xcc_id();
        __builtin_amdgcn_s_waitcnt(0);
        unsigned nloc = st[0], nx = st[1];
        if (nloc == 0u) { xcd_barrier_complete(bar, x, nloc, nx); st[0] = nloc; st[1] = nx; }
        const unsigned old = xb_add(&bar[XB_XSUB(x)], 1u);
        const unsigned gen = old / nloc;
        if (old + 1u == (gen + 1u) * nloc) {
            __builtin_amdgcn_fence(__ATOMIC_RELEASE, "agent");
            asm volatile("s_waitcnt vmcnt(0)" ::: "memory");
            const unsigned og = xb_add(&bar[XB_TOP], 1u);
            const unsigned tg = og / nx;
            if (og + 1u == (tg + 1u) * nx) xb_add(&bar[XB_TOPGEN], 1u);
            else XB_SPIN(xb_ld(&bar[XB_TOPGEN]) == tg, bar);
            __builtin_amdgcn_fence(__ATOMIC_ACQUIRE, "agent");
            xb_add(&bar[XB_XGEN(x)], 1u);
            asm volatile("s_waitcnt vmcnt(0)" ::: "memory");
        } else {
            XB_SPIN(xb_ld(&bar[XB_XGEN(x)]) == gen, bar);
            __builtin_amdgcn_fence(__ATOMIC_ACQUIRE, "agent");
            asm volatile("s_waitcnt vmcnt(0)" ::: "memory");
        }
    }
    __syncthreads();
}

#ifndef PPL
#define PPL 5
#endif
#ifndef NA_PROBE_SKIP
#define NA_PROBE_SKIP 0
#endif
constexpr int N_PHASES = 1 + PPL * DEPTH;
#ifndef REP0
#define REP0 1
#endif
#ifndef REPN
#define REPN 1
#endif
#ifndef REPS
#define REPS 1
#endif
#ifndef REP2
#define REP2 1
#endif
#ifndef REP3
#define REP3 1
#endif
#ifndef REPP
#define REPP 1
#endif
__global__ void __launch_bounds__(512, 2) fwd(Params p_, int ph_lo, int ph_hi) {
    extern __shared__ __attribute__((aligned(16))) unsigned char shm[];
    LAS unsigned char* lds = (LAS unsigned char*)shm;
    volatile LAS unsigned* xst = (volatile LAS unsigned*)(lds + 131072);
    if (threadIdx.x == 0) { xst[0] = 0u; xst[1] = 0u; (void)xb_add(&((unsigned*)(p_.ws + WS_BAR))[XB_XCNT(xb_xcc_id())], 1u); }
    __syncthreads();
    for (int ph = ph_lo; ph < ph_hi; ++ph) {
        if (ph != ph_lo) {
            if (ph == 1) cg::this_grid().sync();
            else { const __attribute__((address_space(4))) Params* pb = (const __attribute__((address_space(4))) Params*)__builtin_amdgcn_kernarg_segment_ptr(); xcd_barrier((unsigned*)(pb->ws + WS_BAR), xst); }
        }
        int tid = threadIdx.x; asm volatile("" : "+v"(tid));
        const __attribute__((address_space(4))) Params* pp = (const __attribute__((address_space(4))) Params*)__builtin_amdgcn_kernarg_segment_ptr(); asm volatile("" : "+s"(pp));
        Params p;
        p.x = pp->x; p.pre_g = pp->pre_g; p.post_g = pp->post_g; p.w_in = pp->w_in; p.rpb = pp->rpb; p.ln_g = pp->ln_g; p.ln_b = pp->ln_b; p.sg_w = pp->sg_w; p.sg_b = pp->sg_b;
        p.w_pa = pp->w_pa; p.w_pb = pp->w_pb; p.w_out = pp->w_out; p.out = pp->out; p.ws = pp->ws;
        bf16_t* H = (bf16_t*)(p.ws + WS_H); bf16_t* VT = (bf16_t*)(p.ws + WS_VT); bf16_t* PROJ = (bf16_t*)(p.ws + WS_PROJ);
        float* T1 = (float*)(p.ws + WS_PROJ);
        float* OUT = T1;
        if (ph == 0) { for (int rep = 0; rep < REPP; ++rep) { prologue(p, lds, tid); __syncthreads(); } continue; }
        const int layer = (ph - 1) / PPL, kk = (ph - 1) % PPL, k = (PPL == 6) ? (kk == 0 ? 0 : kk == 1 ? 5 : kk - 1) : kk;
        const unsigned char* wl = p.ws + WS_W + layer * SZ_LAYER_W;
        #if PPL == 6
        if (k == 5) { na_phase<NA_PROBE_SKIP>(p, layer, lds, tid); } else
#endif
        if (k == 1) { na_phase<0>(p, layer, lds, tid); if (k == 1) { sg_phase(p, layer, lds, tid); __syncthreads(); } }
        else if (k == 4) {
            post_rows(layer == 0 ? p.x : p.out, PROJ, p.post_g + layer * DM, p.out, (layer + 1 < DEPTH) ? p.pre_g + (layer + 1) * DM : nullptr, H, tid);
        } else {
            const int njobs = (k == 0) ? 2 : 1, reps = (k == 0) ? REP0 : (k == 2) ? REP2 : REP3;
            for (int jj = 0; jj < njobs * reps; ++jj) { const int j = jj % njobs;
                pg8::Gemm g; pg8::Epi E; E.obf = nullptr; E.ldo = 0; E.sigcol = 0x7fffffff; E.gate = nullptr; E.ldg = 0; E.kt = nullptr;
                if (k == 0 && j == 0) { g.A = H; g.lda = DM; g.Bt = (const bf16_t*)(wl + OFF_WIN); g.ldb = DM; g.M = NTOK; g.N = NP; g.K = DM; E.mode = 0; E.obf = PROJ; E.ldo = NP; E.sigcol = GA_OFF; E.kt = (bf16_t*)(p.ws + WS_KT); }
                else if (k == 0) { g.A = (const bf16_t*)(wl + OFF_WIN) + (size_t)NP * DM; g.lda = DM; g.Bt = H; g.ldb = DM; g.M = 2048; g.N = NTOK; g.K = DM; E.mode = 4; E.obf = VT; E.ldo = 0; }
                else if (k == 2) { g.A = H; g.lda = DM; g.Bt = (const bf16_t*)(wl + OFF_WPA); g.ldb = DM; g.M = NTOK; g.N = DM; g.K = DM; E.mode = 2; E.gate = PROJ + GA_OFF; E.ldg = NP; E.obf = VT; E.ldo = DM; }
                else { g.A = VT; g.lda = DM; g.Bt = (const bf16_t*)(wl + OFF_WOUT); g.ldb = DM; g.M = NTOK; g.N = DM; g.K = DM; E.mode = 0; E.obf = PROJ; E.ldo = DM; }
                pg8::StaticOrder S; S.init(g.M, g.N, (int)gridDim.x, (int)blockIdx.x);
                pg8::gemm_phase(lds, g, S, E, tid);
                __syncthreads();
            }
        }
    }
}

extern "C" void kernel_launch(void* const* d_in, const int* in_sizes, int n_in, void* d_out, int out_size, void* d_ws, size_t ws_size, hipStream_t stream) {
    static int grid = 0;
    if (!grid) {
        if (n_in != 12 || in_sizes[0] != NTOK * DM || out_size != NTOK * DM || ws_size < WS_END) {
            fprintf(stderr, "kernel_launch: unexpected shapes (n_in %d, in0 %d, out %d, ws %zu, need %zu)\n", n_in, n_in > 0 ? in_sizes[0] : -1, out_size, ws_size, (size_t)WS_END); return; }
        int dev = 0, cus = 0, per_cu = 0;
        (void)hipGetDevice(&dev); (void)hipDeviceGetAttribute(&cus, hipDeviceAttributeMultiprocessorCount, dev);
        (void)hipFuncSetAttribute((const void*)fwd, hipFuncAttributeMaxDynamicSharedMemorySize, LDS_BYTES);
        (void)hipOccupancyMaxActiveBlocksPerMultiprocessor(&per_cu, (const void*)fwd, 512, LDS_BYTES);
        if (per_cu < 1) { fprintf(stderr, "kernel_launch: occupancy query says %d blocks per CU\n", per_cu); per_cu = 1; }
        grid = cus * per_cu;
    }
    Params p{};
    p.x = (const float*)d_in[0]; p.pre_g = (const float*)d_in[1]; p.post_g = (const float*)d_in[2]; p.w_in = (const float*)d_in[3]; p.rpb = (const float*)d_in[4];
    p.ln_g = (const float*)d_in[5]; p.ln_b = (const float*)d_in[6]; p.sg_w = (const float*)d_in[7]; p.sg_b = (const float*)d_in[8];
    p.w_pa = (const float*)d_in[9]; p.w_pb = (const float*)d_in[10]; p.w_out = (const float*)d_in[11]; p.out = (float*)d_out; p.ws = (unsigned char*)d_ws;
    (void)hipMemsetAsync((unsigned char*)d_ws + WS_BAR, 0, XCD_BAR_WORDS * 4, stream);
#ifdef MULTI_LAUNCH
    for (int ph = 0; ph < N_PHASES; ++ph) hipLaunchKernelGGL(fwd, dim3(grid), dim3(512), LDS_BYTES, stream, p, ph, ph + 1);
#else
    int lo = 0, hi = N_PHASES;
    void* args[] = {&p, &lo, &hi};
    hipError_t e = hipLaunchCooperativeKernel((const void*)fwd, dim3(grid), dim3(512), args, LDS_BYTES, stream);
    if (e != hipSuccess) fprintf(stderr, "cooperative launch failed: %s (grid %d)\n", hipGetErrorString(e), grid);
#endif
}
```

```cpp
#include <hip/hip_runtime.h>
#include <hip/hip_cooperative_groups.h>
#include <cstdio>
#include <cstdint>
namespace cg = cooperative_groups;

#define LAS __attribute__((address_space(3)))
typedef unsigned short bf16_t;
typedef short bf16x8 __attribute__((ext_vector_type(8)));
typedef float f32x4 __attribute__((ext_vector_type(4)));
typedef unsigned u32x4 __attribute__((ext_vector_type(4)));
typedef unsigned u32x2 __attribute__((ext_vector_type(2)));

constexpr int DM = 2048, NTOK = 32768, SEQ = 16384, NIN = 11264, DEPTH = 2;
constexpr int NP = 9216;
constexpr int Q_OFF = 0, K_OFF = 1024, ZA_OFF = 2048, U_OFF = 3072, ZB_OFF = 4096, GA_OFF = 5120, GB_OFF = 7168;
constexpr int RPB_N = 8 * 15 * 31;
constexpr size_t SZ_WIN = (size_t)NIN * DM * 2, SZ_WP = (size_t)DM * 1024 * 2, SZ_WOUT = (size_t)DM * DM * 2, SZ_SGW = (size_t)8 * 128 * 128 * 2;
constexpr size_t OFF_WIN = 0, OFF_WPA = OFF_WIN + SZ_WIN, OFF_WPB = OFF_WPA + SZ_WP, OFF_WOUT = OFF_WPB + SZ_WP, OFF_SGW = OFF_WOUT + SZ_WOUT, SZ_LAYER_W = OFF_SGW + SZ_SGW;
constexpr size_t WS_W = 0, WS_H = WS_W + DEPTH * SZ_LAYER_W, WS_VT = WS_H + (size_t)NTOK * DM * 2, WS_PROJ = WS_VT + (size_t)2048 * NTOK * 2,
                 WS_BAR = WS_PROJ + (size_t)NTOK * NP * 2, WS_KT = WS_BAR + 16384, WS_END = WS_KT + (size_t)NTOK * 1024 * 2;
constexpr int LDS_BYTES = 131072 + 64;

struct Params {
    const float* x; const float* pre_g; const float* post_g; const float* w_in; const float* rpb; const float* ln_g; const float* ln_b;
    const float* sg_w; const float* sg_b; const float* w_pa; const float* w_pb; const float* w_out; float* out; unsigned char* ws;
};

__device__ __forceinline__ unsigned f2bf(float f) { unsigned u = __builtin_bit_cast(unsigned, f); return (u + 0x7fffu + ((u >> 16) & 1u)) >> 16; }
__device__ __forceinline__ unsigned cvt_pk_bf16(float lo, float hi) { unsigned r; asm volatile("v_cvt_pk_bf16_f32 %0, %1, %2" : "=v"(r) : "v"(lo), "v"(hi)); return r; }
__device__ __forceinline__ float bflo(unsigned w) { return __builtin_bit_cast(float, w << 16); }
__device__ __forceinline__ float bfhi(unsigned w) { return __builtin_bit_cast(float, w & 0xffff0000u); }
__device__ __forceinline__ float sigmoidf_(float v) { return __builtin_amdgcn_rcpf(1.0f + __expf(-v)); }
__device__ __forceinline__ float siluf_(float v) { return v * sigmoidf_(v); }

namespace pg8 {
constexpr int BM = 256, BK = 64, HALF = 128, HTB = HALF * BK * 2, STAGE_BYTES = 8 * HTB, NXCD = 8, WGM = 8;
__host__ __device__ __forceinline__ int lds_byte(int r, int c) { const int st = (r >> 4) * 2 + (c >> 5), rr = r & 15, cc = c & 31, ob = rr * 64 + cc * 2; return st * 1024 + (ob ^ (((ob >> 9) & 1) << 5)); }
__host__ __device__ __forceinline__ void stage_rc(int b, int& R, int& C) { const int st = b / 1024, sb = b % 1024, swz = sb ^ (((sb >> 9) & 1) << 5); R = (st >> 1) * 16 + swz / 64; C = (st & 1) * 32 + (swz % 64) / 2; }
__host__ __device__ __forceinline__ int perm32(int rho) { const int n = rho >> 4, i = rho & 15; return 8 * (i >> 2) + 4 * n + (i & 3); }

struct Unit { int pm, pn; };
struct Gemm { const bf16_t* A; const bf16_t* Bt; int M, N, K, lda, ldb; };

struct StaticOrder {
    int nM, nN, nwg, G, c;
    __device__ void init(int M, int N, int G_, int c_) { nM = M / BM; nN = N / BM; nwg = nM * nN; G = G_; c = c_; }
    __device__ bool next(int i, Unit& u) const {
        const long L = (long)i * G + c; if (L >= nwg) return false;
        int wgid = (int)L; { const int q = nwg / NXCD, r = nwg % NXCD, xcd = wgid % NXCD, off = wgid / NXCD; wgid = (xcd < r ? xcd * (q + 1) : r * (q + 1) + (xcd - r) * q) + off; }
        const int nig = WGM * nN, gid = wgid / nig, fm = gid * WGM, gsz = (nM - fm) < WGM ? (nM - fm) : WGM;
        u.pm = fm + ((wgid % nig) % gsz); u.pn = (wgid % nig) / gsz; return true;
    }
};

struct Epi {
    int mode;
    bf16_t* obf; int ldo;
    int sigcol;
    bf16_t* kt;
    const bf16_t* gate; int ldg;
    __device__ __forceinline__ void operator()(const f32x4 (&acc)[2][2][4][2], const Unit& u, int wr, int wc, int fr, int fq) const {
        const int row0 = u.pm * BM + wr * 64 + fr, col0 = u.pn * BM + wc * 32 + 8 * fq;
        if (mode == 2) {
#pragma unroll
            for (int ai = 0; ai < 2; ++ai) {
                u32x4 GB[4][2];
#pragma unroll
                for (int m = 0; m < 4; ++m)
#pragma unroll
                    for (int bj = 0; bj < 2; ++bj) GB[m][bj] = *(const u32x4*)(gate + (size_t)(row0 + ai * HALF + m * 16) * ldg + col0 + bj * HALF + 2048);
                __builtin_amdgcn_sched_barrier(0);
#pragma unroll
                for (int m = 0; m < 4; ++m)
#pragma unroll
                    for (int bj = 0; bj < 2; ++bj) {
                        const u32x4 g = GB[m][bj]; f32x4 v0 = acc[ai][bj][m][0], v1 = acc[ai][bj][m][1];
                        v0[0] *= bflo(g.x); v0[1] *= bfhi(g.x); v0[2] *= bflo(g.y); v0[3] *= bfhi(g.y); v1[0] *= bflo(g.z); v1[1] *= bfhi(g.z); v1[2] *= bflo(g.w); v1[3] *= bfhi(g.w);
                        u32x4 w; w.x = cvt_pk_bf16(v0[0], v0[1]); w.y = cvt_pk_bf16(v0[2], v0[3]); w.z = cvt_pk_bf16(v1[0], v1[1]); w.w = cvt_pk_bf16(v1[2], v1[3]);
                        *(u32x4*)(obf + (size_t)(row0 + ai * HALF + m * 16) * ldo + col0 + bj * HALF) = w;
                    }
                __builtin_amdgcn_sched_barrier(0);
            }
            return;
        }
        if ((mode == 0) && (u.pn * BM >= sigcol)) {
            const int c0 = sigcol + (u.pn - sigcol / BM) * HALF + wc * 32 + 8 * fq;
#pragma unroll
            for (int ai = 0; ai < 2; ++ai)
#pragma unroll
                for (int m = 0; m < 4; ++m) {
                    const size_t row = (size_t)(row0 + ai * HALF + m * 16);
                    float rr[8], sb[8];
#pragma unroll
                    for (int e = 0; e < 8; ++e) { const float ga = acc[ai][0][m][e >> 2][e & 3], gb = acc[ai][1][m][e >> 2][e & 3];
                        const float eb = 1.0f + __expf(-gb); sb[e] = __builtin_amdgcn_rcpf(eb); rr[e] = eb * __builtin_amdgcn_rcpf(1.0f + __expf(-ga)); }
                    u32x4 w; w.x = cvt_pk_bf16(rr[0], rr[1]); w.y = cvt_pk_bf16(rr[2], rr[3]); w.z = cvt_pk_bf16(rr[4], rr[5]); w.w = cvt_pk_bf16(rr[6], rr[7]);
                    *(u32x4*)(obf + row * ldo + c0) = w;
                    w.x = cvt_pk_bf16(sb[0], sb[1]); w.y = cvt_pk_bf16(sb[2], sb[3]); w.z = cvt_pk_bf16(sb[4], sb[5]); w.w = cvt_pk_bf16(sb[6], sb[7]);
                    *(u32x4*)(obf + row * ldo + c0 + 2048) = w;
                }
            return;
        }
        const bool sg = false;
        const bool ktile = (mode == 0) && (kt != nullptr) && (u.pn >= 4) && (u.pn < 8);
#pragma unroll
        for (int ai = 0; ai < 2; ++ai)
#pragma unroll
            for (int m = 0; m < 4; ++m) {
                const size_t row = (size_t)(row0 + ai * HALF + m * 16);
#pragma unroll
                for (int bj = 0; bj < 2; ++bj) {
                    const int col = col0 + bj * HALF;
                    f32x4 v0 = acc[ai][bj][m][0], v1 = acc[ai][bj][m][1];
                    if (sg) {
#pragma unroll
                        for (int e = 0; e < 4; ++e) { v0[e] = sigmoidf_(v0[e]); v1[e] = sigmoidf_(v1[e]); }
                    }
                    u32x4 w; w.x = cvt_pk_bf16(v0[0], v0[1]); w.y = cvt_pk_bf16(v0[2], v0[3]); w.z = cvt_pk_bf16(v1[0], v1[1]); w.w = cvt_pk_bf16(v1[2], v1[3]);
                    if (ktile) __builtin_nontemporal_store(w, (u32x4*)(kt + (((row >> 6) * 8 + (size_t)((u.pn - 4) * 2 + bj)) * 64 + (row & 63)) * 128 + (wc * 32 + 8 * fq)));
                    else if (mode == 0) __builtin_nontemporal_store(w, (u32x4*)(obf + row * ldo + col));
                    else __builtin_nontemporal_store(w, (u32x4*)(obf + ((size_t)(col >> 6) * 2048 + row) * 64 + (col & 63)));
                }
            }
    }
    __device__ __forceinline__ void mid(f32x4 (&acc)[2][2][4][2], const Unit& u, int wr, int wc, int fr, int fq) const {
        int row0 = u.pm * BM + wr * 64 + fr, col0 = u.pn * BM + wc * 32 + 8 * fq;
        asm volatile("" : "+v"(row0), "+v"(col0));
        u32x4 RT[2][4][2];
#pragma unroll
        for (int ai = 0; ai < 2; ++ai)
#pragma unroll
            for (int m = 0; m < 4; ++m)
#pragma unroll
                for (int bj = 0; bj < 2; ++bj) RT[ai][m][bj] = *(const u32x4*)(gate + (size_t)(row0 + ai * HALF + m * 16) * ldg + col0 + bj * HALF);
        __builtin_amdgcn_sched_barrier(0);
#pragma unroll
        for (int ai = 0; ai < 2; ++ai)
#pragma unroll
            for (int m = 0; m < 4; ++m)
#pragma unroll
                for (int bj = 0; bj < 2; ++bj) {
                    const unsigned rw[4] = {RT[ai][m][bj].x, RT[ai][m][bj].y, RT[ai][m][bj].z, RT[ai][m][bj].w};
#pragma unroll
                    for (int i = 0; i < 4; ++i) { acc[ai][bj][m][i >> 1][(i & 1) * 2] *= bflo(rw[i]); acc[ai][bj][m][i >> 1][(i & 1) * 2 + 1] *= bfhi(rw[i]); }
                }
        __builtin_amdgcn_sched_barrier(0);
    }
};

__device__ __forceinline__ void gemm_phase(LAS unsigned char* lds, const Gemm g, const StaticOrder& S, const Epi& E, const int tid) {
    const int wid = __builtin_amdgcn_readfirstlane(tid >> 6), lane = tid & 63, wr = wid >> 2, wc = wid & 3, fr = lane & 15, fq = lane >> 4;
    const int K = g.K, nt = K / BK;
    unsigned voffA[2], voffB[2];
#pragma unroll
    for (int i = 0; i < 2; ++i) { int R, C; stage_rc(tid * 16 + i * 8192, R, C); const int Rb = (R & ~31) + perm32(R & 31);
        voffA[i] = (unsigned)(R * g.lda + C) * 2u; voffB[i] = (unsigned)(Rb * g.ldb + C) * 2u; }
    const size_t kstep = (size_t)(BK * 2);
    const size_t hstepA = (size_t)HALF * g.lda * 2, hstepB = (size_t)HALF * g.ldb * 2;
    const size_t tstepA = 2 * hstepA, tstepB = 2 * hstepB;
    const unsigned ldsw = (unsigned)wid * 1024u;
    const int aoff = lds_byte(wr * 64 + fr, fq * 8), boff = lds_byte(wc * 32 + fr, fq * 8);
#define PG8_SA(b, h) (((b) * 2 + (h)) * HTB)
#define PG8_SB(b, h) ((4 + (b) * 2 + (h)) * HTB)
#define PG8_STAGE(bufoff, gbase, voff) do { _Pragma("unroll") for (int _i = 0; _i < 2; ++_i) \
        __builtin_amdgcn_global_load_lds((const unsigned*)((const char*)(gbase) + (voff)[_i]), (LAS unsigned*)(lds + (bufoff) + ldsw + _i * 8192), 16, 0, 0); } while (0)
#define PG8_LDA(dst, b, h) do { _Pragma("unroll") for (int m = 0; m < 4; ++m) _Pragma("unroll") for (int k = 0; k < 2; ++k) dst[m][k] = *(const LAS bf16x8*)(lds + PG8_SA(b, h) + aoff + m * 2048 + k * 1024); } while (0)
#define PG8_LDB(dst, b, h) do { _Pragma("unroll") for (int n = 0; n < 2; ++n) _Pragma("unroll") for (int k = 0; k < 2; ++k) dst[n][k] = *(const LAS bf16x8*)(lds + PG8_SB(b, h) + boff + n * 2048 + k * 1024); } while (0)
#define PG8_MMA(ai, bj, At, Bt) do { __builtin_amdgcn_s_setprio(1); _Pragma("unroll") for (int m = 0; m < 4; ++m) _Pragma("unroll") for (int n = 0; n < 2; ++n) _Pragma("unroll") for (int k = 0; k < 2; ++k) \
        acc[ai][bj][m][n] = __builtin_amdgcn_mfma_f32_16x16x32_bf16(Bt[n][k], At[m][k], acc[ai][bj][m][n], 0, 0, 0); __builtin_amdgcn_s_setprio(0); } while (0)
#define PG8_WAIT_V(n) asm volatile("s_waitcnt vmcnt(" #n ")" ::: "memory")
#define PG8_WAIT_L(n) asm volatile("s_waitcnt lgkmcnt(" #n ")" ::: "memory")
#define PG8_BAR __builtin_amdgcn_s_barrier()
#define PG8_SCHED __builtin_amdgcn_sched_barrier(0)
    Unit cur, nxt; int ui = 0;
    if (!S.next(0, cur)) return;
    f32x4 acc[2][2][4][2];
#pragma unroll
    for (int a = 0; a < 2; ++a)
#pragma unroll
        for (int b = 0; b < 2; ++b)
#pragma unroll
            for (int m = 0; m < 4; ++m)
#pragma unroll
                for (int n = 0; n < 2; ++n) acc[a][b][m][n] = (f32x4){0.f, 0.f, 0.f, 0.f};
    bf16x8 At[4][2], B0[2][2], B1[2][2];
    const char* cA = (const char*)g.A + (size_t)cur.pm * tstepA; const char* cB = (const char*)g.Bt + (size_t)cur.pn * tstepB;
    PG8_STAGE(PG8_SB(0, 0), cB, voffB); PG8_STAGE(PG8_SB(0, 1), cB + hstepB, voffB); PG8_STAGE(PG8_SA(0, 0), cA, voffA); PG8_STAGE(PG8_SA(0, 1), cA + hstepA, voffA);
    if (wr == 1) PG8_BAR;
    PG8_WAIT_V(2); PG8_BAR;
    PG8_STAGE(PG8_SB(1, 0), cB + kstep, voffB); PG8_STAGE(PG8_SA(1, 0), cA + kstep, voffA); PG8_STAGE(PG8_SB(1, 1), cB + hstepB + kstep, voffB);
    PG8_WAIT_V(6); PG8_BAR;
    for (;;) {
        const bool has_next = S.next(ui + 1, nxt);
        const char* nA = has_next ? (const char*)g.A + (size_t)nxt.pm * tstepA : cA; const char* nB = has_next ? (const char*)g.Bt + (size_t)nxt.pn * tstepB : cB;
        for (int t = 0; t < nt; t += 2) {
            if (E.mode == 2 && t == (nt >> 1)) E.mid(acc, cur, wr, wc, fr, fq);
            const bool last = (t == nt - 2);
            const char* a1 = cA + (size_t)(t + 1) * kstep;
            const char* a2 = last ? nA : cA + (size_t)(t + 2) * kstep; const char* b2 = last ? nB : cB + (size_t)(t + 2) * kstep;
            const char* a3 = a2 + kstep; const char* b3 = b2 + kstep;
            PG8_LDB(B0, 0, 0); PG8_LDB(B1, 0, 1); PG8_SCHED; PG8_LDA(At, 0, 0); PG8_STAGE(PG8_SA(1, 1), a1 + hstepA, voffA);
            PG8_WAIT_V(8); PG8_WAIT_L(0); PG8_BAR; PG8_MMA(0, 0, At, B0); PG8_MMA(0, 1, At, B1); PG8_BAR; PG8_SCHED;
            PG8_LDA(At, 0, 1); PG8_STAGE(PG8_SB(0, 0), b2, voffB); PG8_STAGE(PG8_SB(0, 1), b2 + hstepB, voffB); PG8_STAGE(PG8_SA(0, 0), a2, voffA);
            PG8_WAIT_V(8); PG8_WAIT_L(0); PG8_BAR; PG8_MMA(1, 0, At, B0); PG8_MMA(1, 1, At, B1); PG8_BAR; PG8_SCHED;
            PG8_LDB(B0, 1, 0); PG8_LDB(B1, 1, 1); PG8_SCHED; PG8_LDA(At, 1, 0); PG8_STAGE(PG8_SA(0, 1), a2 + hstepA, voffA);
            PG8_WAIT_V(8); PG8_WAIT_L(0); PG8_BAR; PG8_MMA(0, 0, At, B0); PG8_MMA(0, 1, At, B1); PG8_BAR; PG8_SCHED;
            PG8_LDA(At, 1, 1); PG8_STAGE(PG8_SB(1, 0), b3, voffB); PG8_STAGE(PG8_SB(1, 1), b3 + hstepB, voffB); PG8_STAGE(PG8_SA(1, 0), a3, voffA);
            PG8_WAIT_V(8); PG8_WAIT_L(0); PG8_BAR; PG8_MMA(1, 0, At, B0); PG8_MMA(1, 1, At, B1); PG8_BAR; PG8_SCHED;
        }
        if (wr == 0) PG8_BAR;
        E(acc, cur, wr, wc, fr, fq);
#ifdef EPI2
        __builtin_amdgcn_sched_barrier(0); E(acc, cur, wr, wc, fr, fq);
#endif
        if (!has_next) break;
#pragma unroll
        for (int a = 0; a < 2; ++a)
#pragma unroll
            for (int b = 0; b < 2; ++b)
#pragma unroll
                for (int m = 0; m < 4; ++m)
#pragma unroll
                    for (int n = 0; n < 2; ++n) acc[a][b][m][n] = (f32x4){0.f, 0.f, 0.f, 0.f};
        cur = nxt; cA = nA; cB = nB; ++ui;
        if (wr == 1) PG8_BAR;
    }
    PG8_WAIT_V(0);
    PG8_BAR;
#undef PG8_SA
#undef PG8_SB
#undef PG8_STAGE
#undef PG8_LDA
#undef PG8_LDB
#undef PG8_MMA
#undef PG8_WAIT_V
#undef PG8_WAIT_L
#undef PG8_BAR
#undef PG8_SCHED
}
}

__device__ __forceinline__ void convert_tile(const float* W, bf16_t* Wt, int K, int N, int k0, int n0, int orow0, LAS bf16_t* tl, const int tid, int ldw, int kofs) {
    { const int kk = tid >> 4, n4 = (tid & 15) * 4;
#pragma unroll
      for (int h = 0; h < 2; ++h) { const int k = kk + 32 * h; const f32x4 v = *(const f32x4*)(W + (size_t)(k0 + k) * N + n0 + n4);
#pragma unroll
          for (int e = 0; e < 4; ++e) tl[(n4 + e) * 72 + k] = (bf16_t)f2bf(v[e]); } }
    __syncthreads();
    { const int n = tid >> 3, ks = (tid & 7) * 8; const u32x4 w = *(const LAS u32x4*)(tl + n * 72 + ks);
      *(u32x4*)(Wt + (size_t)(orow0 + n) * ldw + kofs + k0 + ks) = w; }
    __syncthreads();
}
__device__ __forceinline__ int win_row(int n0) {
    const int seg = n0 >> 10, r = n0 & 1023;
    switch (seg) { case 0: return r; case 1: return 1024 + r; case 2: return 9216 + r; case 3: return 2048 + r; case 4: return 3072 + r; case 5: return 10240 + r; case 6: return 4096 + r;
                   case 7: case 8: { const int c = n0 - 7168; return 5120 + (c >> 7) * 256 + (c & 127); }
                   default: { const int c = n0 - 9216; return 5120 + (c >> 7) * 256 + 128 + (c & 127); } }
}

__device__ __forceinline__ void rms_rows(const float* x, const float* g, bf16_t* H, const int tid) {
    const int wid = tid >> 6, lane = tid & 63, step = gridDim.x * 8;
    int row = blockIdx.x * 8 + wid;
    f32x4 v[8], vn[8], gg[8];
#pragma unroll
    for (int i = 0; i < 8; ++i) gg[i] = *(const f32x4*)(g + i * 256 + lane * 4);
    if (row < NTOK) {
#pragma unroll
        for (int i = 0; i < 8; ++i) v[i] = *(const f32x4*)(x + (size_t)row * DM + i * 256 + lane * 4); }
    for (; row < NTOK; row += step) {
        const int nrow = row + step;
        if (nrow < NTOK) {
#pragma unroll
            for (int i = 0; i < 8; ++i) vn[i] = *(const f32x4*)(x + (size_t)nrow * DM + i * 256 + lane * 4); }
        float ss = 0.f;
#pragma unroll
        for (int i = 0; i < 8; ++i) ss += v[i][0] * v[i][0] + v[i][1] * v[i][1] + v[i][2] * v[i][2] + v[i][3] * v[i][3];
#pragma unroll
        for (int o = 32; o > 0; o >>= 1) ss += __shfl_xor(ss, o);
        const float rstd = __builtin_amdgcn_rsqf(ss * (1.0f / DM) + 1e-6f);
#pragma unroll
        for (int i = 0; i < 8; ++i) {
            u32x2 w; w.x = cvt_pk_bf16(v[i][0] * rstd * gg[i][0], v[i][1] * rstd * gg[i][1]); w.y = cvt_pk_bf16(v[i][2] * rstd * gg[i][2], v[i][3] * rstd * gg[i][3]);
            *(u32x2*)(H + (size_t)row * DM + i * 256 + lane * 4) = w; }
#pragma unroll
        for (int i = 0; i < 8; ++i) v[i] = vn[i];
    }
}

__device__ __forceinline__ void post_rows(const float* xin, const bf16_t* OUT, const float* pg, float* out, const float* ng, bf16_t* H, const int tid) {
    const int wid = tid >> 6, lane = tid & 63, step = gridDim.x * 8;
    int row = blockIdx.x * 8 + wid;
    u32x2 ow[8], own[8]; f32x4 xw[8], xwn[8], pgv[8], ngv[8];
#pragma unroll
    for (int i = 0; i < 8; ++i) { pgv[i] = *(const f32x4*)(pg + i * 256 + lane * 4); ngv[i] = ng ? *(const f32x4*)(ng + i * 256 + lane * 4) : (f32x4){0.f, 0.f, 0.f, 0.f}; }
    if (row < NTOK) {
#pragma unroll
        for (int i = 0; i < 8; ++i) { ow[i] = *(const u32x2*)(OUT + (size_t)row * DM + i * 256 + lane * 4); xw[i] = *(const f32x4*)(xin + (size_t)row * DM + i * 256 + lane * 4); } }
    for (; row < NTOK; row += step) {
        const int nrow = row + step;
        if (nrow < NTOK) {
#pragma unroll
            for (int i = 0; i < 8; ++i) { own[i] = *(const u32x2*)(OUT + (size_t)nrow * DM + i * 256 + lane * 4); xwn[i] = *(const f32x4*)(xin + (size_t)nrow * DM + i * 256 + lane * 4); } }
        f32x4 o[8]; float ss = 0.f;
#pragma unroll
        for (int i = 0; i < 8; ++i) { const u32x2 w = ow[i];
            o[i][0] = bflo(w.x); o[i][1] = bfhi(w.x); o[i][2] = bflo(w.y); o[i][3] = bfhi(w.y); ss += o[i][0] * o[i][0] + o[i][1] * o[i][1] + o[i][2] * o[i][2] + o[i][3] * o[i][3]; }
#pragma unroll
        for (int s = 32; s > 0; s >>= 1) ss += __shfl_xor(ss, s);
        const float rstd = __builtin_amdgcn_rsqf(ss * (1.0f / DM) + 1e-6f);
        float s2 = 0.f;
#pragma unroll
        for (int i = 0; i < 8; ++i) { const f32x4 gg = pgv[i]; const f32x4 xv = xw[i];
            f32x4 r; r[0] = xv[0] + o[i][0] * rstd * gg[0]; r[1] = xv[1] + o[i][1] * rstd * gg[1]; r[2] = xv[2] + o[i][2] * rstd * gg[2]; r[3] = xv[3] + o[i][3] * rstd * gg[3];
            *(f32x4*)(out + (size_t)row * DM + i * 256 + lane * 4) = r; o[i] = r; s2 += r[0] * r[0] + r[1] * r[1] + r[2] * r[2] + r[3] * r[3]; }
        if (ng) {
#pragma unroll
            for (int s = 32; s > 0; s >>= 1) s2 += __shfl_xor(s2, s);
            const float rs2 = __builtin_amdgcn_rsqf(s2 * (1.0f / DM) + 1e-6f);
#pragma unroll
            for (int i = 0; i < 8; ++i) { const f32x4 gg = ngv[i];
                u32x2 w; w.x = cvt_pk_bf16(o[i][0] * rs2 * gg[0], o[i][1] * rs2 * gg[1]); w.y = cvt_pk_bf16(o[i][2] * rs2 * gg[2], o[i][3] * rs2 * gg[3]);
                *(u32x2*)(H + (size_t)row * DM + i * 256 + lane * 4) = w; }
        }
#pragma unroll
        for (int i = 0; i < 8; ++i) { ow[i] = own[i]; xw[i] = xwn[i]; }
    }
}

constexpr int NA_SLOT = 18432;
constexpr int NA_RPB_OFF = 3 * NA_SLOT;
#define NA_BAR() do { asm volatile("s_waitcnt lgkmcnt(0)" ::: "memory"); __builtin_amdgcn_s_barrier(); asm volatile("" ::: "memory"); } while (0)

struct NaUnit { int b, r0, head, rsA, delta; };
__device__ __forceinline__ NaUnit na_decode(int u) {
    NaUnit n; const int cc = u & 255, idx = cc >> 3; n.head = u >> 8; n.b = idx >> 4; n.r0 = 2 * ((cc & 7) * 16 + (idx & 15));
    n.rsA = min(max(n.r0 - 4, 0), 248); n.delta = min(max(n.r0 - 3, 0), 248) - n.rsA; return n; }

template <int I> __device__ __forceinline__ void na_issue(u32x4 (&R)[2], const bf16_t* KT, const bf16_t* VT, const NaUnit& n, const int tid) {
    if constexpr (I < 9) {
        const int row = min(n.rsA + I, 255);
        const bf16_t* base = KT + ((size_t)((n.b * 256 + row) * 8 + n.head)) * 8192 + tid * 8;
        R[0] = *(const u32x4*)base; R[1] = *(const u32x4*)(base + 4096);
    } else {
        const int row = min(n.rsA + (I - 9), 255);
        const bf16_t* base = VT + ((size_t)((n.b * 256 + row) * 2048 + n.head * 128)) * 64 + tid * 8;
        R[0] = *(const u32x4*)base; R[1] = *(const u32x4*)(base + 4096);
    }
}
template <int I> __device__ __forceinline__ void na_write(const u32x4 (&R)[2], LAS unsigned char* ring, const int tid) {
    LAS unsigned char* slot = ring + (I % 3) * NA_SLOT;
    if constexpr (I < 9) { LAS unsigned char* d = slot + (tid >> 4) * 288 + (tid & 15) * 16; *(LAS u32x4*)d = R[0]; *(LAS u32x4*)(d + 32 * 288) = R[1]; }
    else { LAS unsigned char* d = slot + (tid >> 3) * 144 + (tid & 7) * 16; *(LAS u32x4*)d = R[0]; *(LAS u32x4*)(d + 64 * 144) = R[1]; }
}

struct NaState { f32x4 s[8][2]; bf16x8 pf[8]; f32x4 o[8]; bf16x8 qf[4]; u32x2 z[8]; float inv; int idx[4]; bool sel[4]; unsigned m01, m23; };

template <int T> __device__ __forceinline__ void na_kstep(NaState& st, const LAS unsigned char* ring, int shift, int kc0, int fr, int fq) {
    const LAS unsigned char* base = ring + ((T + shift) % 3) * NA_SLOT + (kc0 + fr) * 288 + fq * 16;
    bf16x8 kf[2][4];
#pragma unroll
    for (int ct = 0; ct < 2; ++ct)
#pragma unroll
        for (int ks = 0; ks < 4; ++ks) kf[ct][ks] = *(const LAS bf16x8*)(base + ct * 16 * 288 + ks * 64);
    __builtin_amdgcn_sched_barrier(0);
    f32x4 a0 = {0.f, 0.f, 0.f, 0.f}, a1 = {0.f, 0.f, 0.f, 0.f};
#pragma unroll
    for (int ks = 0; ks < 4; ++ks) { a0 = __builtin_amdgcn_mfma_f32_16x16x32_bf16(kf[0][ks], st.qf[ks], a0, 0, 0, 0); a1 = __builtin_amdgcn_mfma_f32_16x16x32_bf16(kf[1][ks], st.qf[ks], a1, 0, 0, 0); }
    st.s[T][0] = a0; st.s[T][1] = a1;
}
template <int T> __device__ __forceinline__ void na_vstep(NaState& st, const LAS unsigned char* ring, int shift, int kc0, int fr, int fq) {
    const LAS unsigned char* vp = ring + ((9 + T + shift) % 3) * NA_SLOT + fr * 144 + (kc0 + 4 * fq) * 2;
    unsigned vph = (unsigned)(size_t)vp + 32u; asm volatile("" : "+v"(vph));
    const LAS unsigned char* vp2 = (const LAS unsigned char*)(size_t)vph;
    u32x2 lo[8], hi[8];
#pragma unroll
    for (int dt = 0; dt < 8; ++dt) { lo[dt] = *(const LAS u32x2*)(vp + dt * 16 * 144); hi[dt] = *(const LAS u32x2*)(vp2 + dt * 16 * 144); }
    __builtin_amdgcn_sched_barrier(0);
#pragma unroll
    for (int dt = 0; dt < 8; ++dt) {
        u32x4 w; w.x = lo[dt].x; w.y = lo[dt].y; w.z = hi[dt].x; w.w = hi[dt].y;
        st.o[dt] = __builtin_amdgcn_mfma_f32_16x16x32_bf16(__builtin_bit_cast(bf16x8, w), st.pf[T], st.o[dt], 0, 0, 0);
    }
}
__device__ __forceinline__ void na_softmax(NaState& st, const LAS float* rp, int head, int drow0) {
    const float scale2 = 0.08838834764831845f * 1.4426950408889634f;
    float mx = -1e30f;
#pragma unroll
    for (int ki = 0; ki < 8; ++ki) {
        const LAS float* row = rp + (head * 15 + drow0 + ki) * 32;
#pragma unroll
        for (int j = 0; j < 4; ++j) { const float sv = st.sel[j] ? st.s[ki][0][j] : st.s[ki][1][j]; const float v = __builtin_fmaf(sv, scale2, row[st.idx[j]]); st.s[ki][0][j] = v; mx = fmaxf(mx, v); }
    }
    mx = fmaxf(mx, __shfl_xor(mx, 16)); mx = fmaxf(mx, __shfl_xor(mx, 32));
    float sum = 0.f;
    const unsigned m01 = st.m01, m23 = st.m23;
#pragma unroll
    for (int ki = 0; ki < 8; ++ki) {
        float e[4];
#pragma unroll
        for (int j = 0; j < 4; ++j) { e[j] = __builtin_amdgcn_exp2f(st.s[ki][0][j] - mx); sum += e[j]; }
        const unsigned p01 = cvt_pk_bf16(e[0], e[1]), p23 = cvt_pk_bf16(e[2], e[3]);
        u32x4 w; w.x = p01 & m01; w.y = p23 & m23; w.z = p01 & ~m01; w.w = p23 & ~m23;
        st.pf[ki] = __builtin_bit_cast(bf16x8, w);
    }
    sum += __shfl_xor(sum, 16); sum += __shfl_xor(sum, 32);
    st.inv = 1.0f / sum;
#pragma unroll
    for (int dt = 0; dt < 8; ++dt) st.o[dt] = (f32x4){0.f, 0.f, 0.f, 0.f};
}

template <int skip> __device__ __forceinline__ void na_phase(const Params& p, int layer, LAS unsigned char* lds, const int tid) {
    LAS float* rp = (LAS float*)(lds + NA_RPB_OFF);
    for (int i = tid; i < 8 * 15 * 32; i += 512) { const int rw = i >> 5, cl = i & 31; rp[i] = (cl < 31) ? p.rpb[layer * RPB_N + rw * 31 + cl] * 1.4426950408889634f : -1e30f; }
    const bf16_t* PROJ = (const bf16_t*)(p.ws + WS_PROJ); const bf16_t* VT = (const bf16_t*)(p.ws + WS_VT); bf16_t* Y = (bf16_t*)(p.ws + WS_H); const bf16_t* KT = (const bf16_t*)(p.ws + WS_KT);
    const int wid = __builtin_amdgcn_readfirstlane(tid >> 6), lane = tid & 63, fr = lane & 15, fq = lane >> 4, ri = wid >> 2, qb = wid & 3;
    const int kc0 = (qb == 0) ? 0 : (qb == 1) ? 8 : (qb == 2) ? 24 : 32, qcol = 16 * qb + fr;
    const int G = (int)gridDim.x, c = (int)blockIdx.x;
    if (c >= 2048) { __syncthreads(); return; }
    LAS unsigned char* ring = lds;
    NaState st; u32x4 R0[2], R1[2], R2[2], R3[2], R4[2], R5[2];
    { const int cs = min(max(qcol - 8, 0), 48); unsigned m01 = 0u, m23 = 0u;
#pragma unroll
      for (int j = 0; j < 4; ++j) { const int k0 = kc0 + 4 * fq + j; const bool v0 = (k0 >= cs) && (k0 < cs + 16);
          st.sel[j] = v0; st.idx[j] = (v0 ? k0 : k0 + 16) - qcol + 15;
          if (v0) { if (j == 0) m01 |= 0xffffu; if (j == 1) m01 |= 0xffff0000u; if (j == 2) m23 |= 0xffffu; if (j == 3) m23 |= 0xffff0000u; } }
      st.m01 = m01; st.m23 = m23; }
    NaUnit cur = na_decode(c);
    na_issue<0>(R0, KT, VT, cur, tid); na_issue<1>(R1, KT, VT, cur, tid); na_issue<2>(R2, KT, VT, cur, tid);
    na_issue<3>(R3, KT, VT, cur, tid); na_issue<4>(R4, KT, VT, cur, tid); na_issue<5>(R5, KT, VT, cur, tid);
    { const size_t qtok = (size_t)(cur.b * SEQ + (cur.r0 + ri) * 64 + qcol);
#pragma unroll
      for (int ks = 0; ks < 4; ++ks) st.qf[ks] = *(const bf16x8*)(PROJ + qtok * NP + Q_OFF + cur.head * 128 + ks * 32 + fq * 8); }
    for (int u = c; u < 2048; u += G) {
        const bool has_next = (u + G) < 2048;
        const NaUnit nxt = has_next ? na_decode(u + G) : cur;
        const int my_r = cur.r0 + ri, shift = ri ? cur.delta : 0, head = cur.head;
        const size_t qtok = (size_t)(cur.b * SEQ + my_r * 64 + qcol);
#define NA_PUT(I, RR, NU, NI) do { if constexpr (!(skip & 8)) { na_write<I>(RR, ring, tid); na_issue<NI>(RR, KT, VT, NU, tid); } } while (0)
        NA_BAR();
        NA_PUT(0, R0, cur, 6); NA_PUT(1, R1, cur, 7);   NA_BAR(); if constexpr (!(skip & 1)) na_kstep<0>(st, ring, shift, kc0, fr, fq);
        NA_PUT(2, R2, cur, 8);                          NA_BAR(); if constexpr (!(skip & 1)) na_kstep<1>(st, ring, shift, kc0, fr, fq);
        NA_PUT(3, R3, cur, 9);                          NA_BAR(); if constexpr (!(skip & 1)) na_kstep<2>(st, ring, shift, kc0, fr, fq);
        NA_PUT(4, R4, cur, 10);                          NA_BAR(); if constexpr (!(skip & 1)) na_kstep<3>(st, ring, shift, kc0, fr, fq);
        NA_PUT(5, R5, cur, 11);                          NA_BAR(); if constexpr (!(skip & 1)) na_kstep<4>(st, ring, shift, kc0, fr, fq);
        NA_PUT(6, R0, cur, 12);                          NA_BAR(); if constexpr (!(skip & 1)) na_kstep<5>(st, ring, shift, kc0, fr, fq);
        NA_PUT(7, R1, cur, 13);                         NA_BAR(); if constexpr (!(skip & 1)) na_kstep<6>(st, ring, shift, kc0, fr, fq);
        NA_PUT(8, R2, cur, 14);                         NA_BAR(); if constexpr (!(skip & 1)) na_kstep<7>(st, ring, shift, kc0, fr, fq);
        if constexpr (!(skip & 2)) na_softmax(st, rp, head, (cur.rsA + shift) - my_r + 7);
        if constexpr (!(skip & 4)) {
#pragma unroll
        for (int dt = 0; dt < 8; ++dt) st.z[dt] = *(const u32x2*)(PROJ + qtok * NP + ZA_OFF + head * 128 + dt * 16 + 4 * fq); }
        NA_BAR();
        NA_PUT(9, R3, cur, 15); NA_PUT(10, R4, cur, 16); NA_BAR(); if constexpr (!(skip & 1)) na_vstep<0>(st, ring, shift, kc0, fr, fq);
        NA_PUT(11, R5, cur, 17);                         NA_BAR(); if constexpr (!(skip & 1)) na_vstep<1>(st, ring, shift, kc0, fr, fq);
        NA_PUT(12, R0, nxt, 0);                         NA_BAR(); if constexpr (!(skip & 1)) na_vstep<2>(st, ring, shift, kc0, fr, fq);
        NA_PUT(13, R1, nxt, 1);                         NA_BAR(); if constexpr (!(skip & 1)) na_vstep<3>(st, ring, shift, kc0, fr, fq);
        NA_PUT(14, R2, nxt, 2);                         NA_BAR(); if constexpr (!(skip & 1)) na_vstep<4>(st, ring, shift, kc0, fr, fq);
        { const size_t nq = (size_t)(nxt.b * SEQ + (nxt.r0 + ri) * 64 + qcol);
#pragma unroll
          for (int ks = 0; ks < 4; ++ks) st.qf[ks] = *(const bf16x8*)(PROJ + nq * NP + Q_OFF + nxt.head * 128 + ks * 32 + fq * 8); }
        NA_PUT(15, R3, nxt, 3);                          NA_BAR(); if constexpr (!(skip & 1)) na_vstep<5>(st, ring, shift, kc0, fr, fq);
        NA_PUT(16, R4, nxt, 4);                          NA_BAR(); if constexpr (!(skip & 1)) na_vstep<6>(st, ring, shift, kc0, fr, fq);
        NA_PUT(17, R5, nxt, 5);                          NA_BAR(); if constexpr (!(skip & 1)) na_vstep<7>(st, ring, shift, kc0, fr, fq);
#undef NA_PUT
        if constexpr (!(skip & 4))
#pragma unroll
        for (int dt = 0; dt < 8; ++dt) {
            const f32x4 o = st.o[dt]; const u32x2 z = st.z[dt]; const float inv = st.inv;
            u32x2 y; y.x = cvt_pk_bf16(o[0] * inv * siluf_(bflo(z.x)), o[1] * inv * siluf_(bfhi(z.x))); y.y = cvt_pk_bf16(o[2] * inv * siluf_(bflo(z.y)), o[3] * inv * siluf_(bfhi(z.y)));
            *(u32x2*)(Y + qtok * DM + head * 128 + dt * 16 + 4 * fq) = y;
        }
        cur = nxt;
    }
    __syncthreads();
}

struct SgPre { u32x4 vs[4]; u32x2 u[8], z[8]; float bb[8]; float lg, lb; };
__device__ __forceinline__ void sg_fetch(SgPre& P, u32x4 (&WR)[4], const char* PROJ, const char* VT, const char* Wsb, const float* lng, const float* lnb, const float* bs,
                                         int chunk, int g, int wid, int fr, int fq, int tid) {
    const int ch = g * 128 + 16 * wid + fr, c4 = g * 128 + 16 * wid + 4 * fq;
    const unsigned woff = (unsigned)g * 32768u + (unsigned)tid * 16u;
#pragma unroll
    for (int i = 0; i < 4; ++i) WR[i] = *(const u32x4*)(Wsb + (size_t)(woff + 8192u * i));
#pragma unroll
    for (int ks = 0; ks < 4; ++ks) { const int t0 = 32 * ks + 8 * fq; const unsigned vo = ((unsigned)((chunk * 2 + (t0 >> 6)) * 2048 + 1024 + ch) * 64u + (unsigned)(t0 & 63)) * 2u; P.vs[ks] = *(const u32x4*)(VT + (size_t)vo); }
    const unsigned uo = ((unsigned)(chunk * 128 + fr) * (unsigned)NP + (unsigned)(U_OFF + c4)) * 2u;
#pragma unroll
    for (int st = 0; st < 8; ++st) { const unsigned o = uo + (unsigned)st * (16u * NP * 2u);
        P.u[st] = *(const u32x2*)(PROJ + (size_t)o); P.z[st] = *(const u32x2*)(PROJ + (size_t)o + (ZB_OFF - U_OFF) * 2); P.bb[st] = bs[g * 128 + st * 16 + fr]; }
    P.lg = lng[ch]; P.lb = lnb[ch];
}
__device__ __forceinline__ void sg_group(const SgPre& P, const LAS unsigned char* wb, const LAS float* mu, const LAS float* rsd, char* Y, int tok0, int g, int wid, int fr, int fq) {
    const float lg = P.lg, lb = P.lb;
    bf16x8 af[4];
#pragma unroll
    for (int ks = 0; ks < 4; ++ks) {
        const int t0 = 32 * ks + 8 * fq; const u32x4 v = P.vs[ks];
        const f32x4 m0 = *(const LAS f32x4*)(mu + t0), m1 = *(const LAS f32x4*)(mu + t0 + 4), r0 = *(const LAS f32x4*)(rsd + t0), r1 = *(const LAS f32x4*)(rsd + t0 + 4);
        u32x4 w;
        w.x = cvt_pk_bf16((bflo(v.x) - m0[0]) * r0[0] * lg + lb, (bfhi(v.x) - m0[1]) * r0[1] * lg + lb);
        w.y = cvt_pk_bf16((bflo(v.y) - m0[2]) * r0[2] * lg + lb, (bfhi(v.y) - m0[3]) * r0[3] * lg + lb);
        w.z = cvt_pk_bf16((bflo(v.z) - m1[0]) * r1[0] * lg + lb, (bfhi(v.z) - m1[1]) * r1[1] * lg + lb);
        w.w = cvt_pk_bf16((bflo(v.w) - m1[2]) * r1[2] * lg + lb, (bfhi(v.w) - m1[3]) * r1[3] * lg + lb);
        af[ks] = __builtin_bit_cast(bf16x8, w);
    }
    const unsigned yo = ((unsigned)(tok0 + fr) * (unsigned)DM + (unsigned)(g * 128 + 16 * wid + 4 * fq)) * 2u;
#pragma unroll
    for (int st = 0; st < 8; ++st) {
        const LAS unsigned char* wp = wb + (st * 16 + fr) * 288 + fq * 16;
        f32x4 a = {0.f, 0.f, 0.f, 0.f};
#pragma unroll
        for (int ks = 0; ks < 4; ++ks) { const bf16x8 wf = *(const LAS bf16x8*)(wp + ks * 64); a = __builtin_amdgcn_mfma_f32_16x16x32_bf16(af[ks], wf, a, 0, 0, 0); }
        const float bb = P.bb[st]; const u32x2 uu = P.u[st], z = P.z[st];
        u32x2 y;
        y.x = cvt_pk_bf16(bflo(uu.x) * (a[0] + bb) * siluf_(bflo(z.x)), bfhi(uu.x) * (a[1] + bb) * siluf_(bfhi(z.x)));
        y.y = cvt_pk_bf16(bflo(uu.y) * (a[2] + bb) * siluf_(bflo(z.y)), bfhi(uu.y) * (a[3] + bb) * siluf_(bfhi(z.y)));
        *(u32x2*)(Y + (size_t)(yo + (unsigned)st * (16u * DM * 2u))) = y;
    }
}
__device__ __forceinline__ void sg_phase(const Params& p, int layer, LAS unsigned char* lds, const int tid) {
    LAS float* red = (LAS float*)(lds + 73728);
    LAS float* mu = (LAS float*)(lds + 73728 + 8192);
    LAS float* rsd = mu + 128;
    const char* PROJ = (const char*)(p.ws + WS_PROJ); const char* VT = (const char*)(p.ws + WS_VT); char* Y = (char*)(p.ws + WS_H) + 2048;
    const char* Wsb = (const char*)(p.ws + WS_W + layer * SZ_LAYER_W + OFF_SGW);
    const float* lng = p.ln_g + layer * 1024; const float* lnb = p.ln_b + layer * 1024; const float* bs = p.sg_b + layer * 1024;
    const int wid = __builtin_amdgcn_readfirstlane(tid >> 6), lane = tid & 63, fr = lane & 15, fq = lane >> 4;
    for (int chunk = blockIdx.x; chunk < 256; chunk += gridDim.x) {
        const int tok0 = chunk * 128;
        __syncthreads();
        SgPre P0, P1; u32x4 WR[4];
        sg_fetch(P0, WR, PROJ, VT, Wsb, lng, lnb, bs, chunk, 0, wid, fr, fq, tid);
        { const int tg = tid & 15; float s1[8], s2[8];
#pragma unroll
          for (int e = 0; e < 8; ++e) { s1[e] = 0.f; s2[e] = 0.f; }
          const unsigned vb = ((unsigned)((chunk * 2 + (tg >> 3)) * 2048 + 1024 + (tid >> 4)) * 64u + (unsigned)((tg & 7) * 8)) * 2u;
#pragma unroll 16
          for (int i = 0; i < 32; ++i) { const u32x4 v = *(const u32x4*)(VT + (size_t)(vb + (unsigned)i * 4096u));
              const unsigned w[4] = {v.x, v.y, v.z, v.w};
#pragma unroll
              for (int e = 0; e < 4; ++e) { const float f0 = bflo(w[e]), f1 = bfhi(w[e]); s1[2 * e] += f0; s1[2 * e + 1] += f1; s2[2 * e] += f0 * f0; s2[2 * e + 1] += f1 * f1; } }
#pragma unroll
          for (int e = 0; e < 8; ++e) { s1[e] += __shfl_xor(s1[e], 16); s1[e] += __shfl_xor(s1[e], 32); s2[e] += __shfl_xor(s2[e], 16); s2[e] += __shfl_xor(s2[e], 32); }
          if (lane < 16) {
#pragma unroll
              for (int e = 0; e < 8; ++e) { red[(wid * 128 + tg * 8 + e) * 2] = s1[e]; red[(wid * 128 + tg * 8 + e) * 2 + 1] = s2[e]; } } }
        NA_BAR();
        if (tid < 128) { float a = 0.f, q = 0.f;
#pragma unroll
            for (int pp = 0; pp < 8; ++pp) { a += red[(pp * 128 + tid) * 2]; q += red[(pp * 128 + tid) * 2 + 1]; }
            const float mean = a * (1.0f / 1024.f); const float var = fmaxf(q * (1.0f / 1024.f) - mean * mean, 0.f);
            mu[tid] = mean; rsd[tid] = __builtin_amdgcn_rsqf(var + 1e-5f); }
        NA_BAR();
#define SG_GROUP(G, B, PC, PN, MORE) do { \
            { LAS unsigned char* wd = lds + (B) * 36864 + (tid >> 4) * 288 + (tid & 15) * 16; \
              _Pragma("unroll") for (int i = 0; i < 4; ++i) *(LAS u32x4*)(wd + i * 32 * 288) = WR[i]; } \
            if (MORE) sg_fetch(PN, WR, PROJ, VT, Wsb, lng, lnb, bs, chunk, (G) + 1, wid, fr, fq, tid); \
            NA_BAR(); \
            sg_group(PC, lds + (B) * 36864, mu, rsd, Y, tok0, (G), wid, fr, fq); } while (0)
#pragma unroll 1
        for (int g2 = 0; g2 < 4; ++g2) { SG_GROUP(2 * g2, 0, P0, P1, true); SG_GROUP(2 * g2 + 1, 1, P1, P0, g2 < 3); }
#undef SG_GROUP
    }
}

struct CvtTile { const float* src; bf16_t* dst; int N, ldw; };
__device__ __forceinline__ CvtTile cvt_decode(const Params& p, int t) {
    constexpr int T_IN = 32 * 176, T_P = 16 * 32, T_LAYER = T_IN + 2 * T_P + 32 * 32;
    const int layer = t / T_LAYER; int r = t % T_LAYER;
    unsigned char* wl = p.ws + WS_W + layer * SZ_LAYER_W; CvtTile c;
    if (r < T_IN) { const int kt = r & 31, nt = r >> 5; c.N = NIN; c.ldw = DM; c.src = p.w_in + (size_t)layer * DM * NIN + (size_t)(kt * 64) * NIN + nt * 64; c.dst = (bf16_t*)(wl + OFF_WIN) + (size_t)win_row(nt * 64) * DM + kt * 64; }
    else if ((r -= T_IN) < T_P) { const int kt = r & 15, nt = r >> 4; c.N = DM; c.ldw = DM; c.src = p.w_pa + (size_t)layer * 1024 * DM + (size_t)(kt * 64) * DM + nt * 64; c.dst = (bf16_t*)(wl + OFF_WPA) + (size_t)(nt * 64) * DM + kt * 64; }
    else if ((r -= T_P) < T_P) { const int kt = r & 15, nt = r >> 4; c.N = DM; c.ldw = DM; c.src = p.w_pb + (size_t)layer * 1024 * DM + (size_t)(kt * 64) * DM + nt * 64; c.dst = (bf16_t*)(wl + OFF_WPA) + (size_t)(nt * 64) * DM + 1024 + kt * 64; }
    else { r -= T_P; const int kt = r & 31, nt = r >> 5; c.N = DM; c.ldw = DM; c.src = p.w_out + (size_t)layer * DM * DM + (size_t)(kt * 64) * DM + nt * 64; c.dst = (bf16_t*)(wl + OFF_WOUT) + (size_t)(nt * 64) * DM + kt * 64; }
    return c;
}
__device__ __forceinline__ void prologue(const Params& p, LAS unsigned char* lds, const int tid) {
    constexpr int T_TOTAL = DEPTH * (32 * 176 + 2 * 16 * 32 + 32 * 32);
    { const int kk = tid >> 4, n4 = (tid & 15) * 4, wn = tid >> 3, wks = (tid & 7) * 8;
      int t = blockIdx.x; f32x4 v0, v1; CvtTile cur;
      if (t < T_TOTAL) { cur = cvt_decode(p, t); v0 = *(const f32x4*)(cur.src + (size_t)kk * cur.N + n4); v1 = *(const f32x4*)(cur.src + (size_t)(kk + 32) * cur.N + n4); }
      for (int it = 0; t < T_TOTAL; t += gridDim.x, ++it) {
          LAS bf16_t* tl = (LAS bf16_t*)lds + (it & 1) * (64 * 72);
#pragma unroll
          for (int e = 0; e < 4; ++e) { tl[(n4 + e) * 72 + kk] = (bf16_t)f2bf(v0[e]); tl[(n4 + e) * 72 + kk + 32] = (bf16_t)f2bf(v1[e]); }
          const CvtTile me = cur;
          if (t + (int)gridDim.x < T_TOTAL) { cur = cvt_decode(p, t + gridDim.x); v0 = *(const f32x4*)(cur.src + (size_t)kk * cur.N + n4); v1 = *(const f32x4*)(cur.src + (size_t)(kk + 32) * cur.N + n4); }
          NA_BAR();
          const u32x4 w = *(const LAS u32x4*)(tl + wn * 72 + wks);
          *(u32x4*)(me.dst + (size_t)wn * me.ldw + wks) = w;
      }
      __syncthreads(); }
    for (int i = blockIdx.x * 512 + tid; i < DEPTH * 8 * 128 * 128 / 4; i += gridDim.x * 512) {
        const int layer = i / (8 * 128 * 128 / 4), e = i % (8 * 128 * 128 / 4);
        const f32x4 v = *(const f32x4*)(p.sg_w + (size_t)layer * 8 * 128 * 128 + e * 4);
        u32x2 w; w.x = cvt_pk_bf16(v[0], v[1]); w.y = cvt_pk_bf16(v[2], v[3]);
        *(u32x2*)((bf16_t*)(p.ws + WS_W + layer * SZ_LAYER_W + OFF_SGW) + e * 4) = w;
    }
    rms_rows(p.x, p.pre_g, (bf16_t*)(p.ws + WS_H), tid);
}

#define XB_TMO      128
#define XB_XCNT(j)  (256  + 64 * (j))
#define XB_XSUB(j)  (1280 + 64 * (j))
#define XB_XGEN(j)  (2304 + 64 * (j))
#define XB_TOP      3328
#define XB_TOPGEN   3392
#define XCD_BAR_WORDS 3456
#define XB_SPIN_CAP (1u << 22)
__device__ __forceinline__ unsigned xb_ld(unsigned* p)              { return __hip_atomic_load(p, __ATOMIC_RELAXED, __HIP_MEMORY_SCOPE_AGENT); }
__device__ __forceinline__ unsigned xb_add(unsigned* p, unsigned v) { return __hip_atomic_fetch_add(p, v, __ATOMIC_RELAXED, __HIP_MEMORY_SCOPE_AGENT); }
__device__ __forceinline__ unsigned xb_xcc_id() { return (unsigned)__builtin_amdgcn_s_getreg((3 << 11) | 20) & 0xFu; }
#define XB_SPIN(cond, bar) do { unsigned _sp = 0; while (cond) { __builtin_amdgcn_s_sleep(1); \
    if ((++_sp & 255u) == 0u) { if (xb_ld(&(bar)[XB_TMO])) break; if (_sp > XB_SPIN_CAP) { atomicAdd(&(bar)[XB_TMO], 1u); break; } } } } while (0)
__device__ __forceinline__ void xcd_barrier_complete(unsigned* bar, unsigned x, unsigned& nloc, unsigned& nx) {
    const unsigned G = gridDim.x * gridDim.y * gridDim.z;
    unsigned sum, cnt, mine, sp = 0u;
    for (;;) {
        sum = 0u; cnt = 0u; mine = 0u;
#pragma unroll
        for (unsigned j = 0; j < 16; ++j) { const unsigned c = xb_ld(&bar[XB_XCNT(j)]); sum += c; cnt += (c > 0u) ? 1u : 0u; mine = (j == x) ? c : mine; }
        if (sum == G) break;
        __builtin_amdgcn_s_sleep(1);
        if ((++sp & 255u) == 0u) { if (xb_ld(&bar[XB_TMO])) break; if (sp > XB_SPIN_CAP) { atomicAdd(&bar[XB_TMO], 1u); break; } }
    }
    nloc = mine > 0u ? mine : 1u; nx = cnt > 0u ? cnt : 1u;
}
__device__ __forceinline__ void xcd_barrier(unsigned* bar, volatile LAS unsigned* st) {
    asm volatile("s_waitcnt vmcnt(0)" ::: "memory");
    __syncthreads();
    if (threadIdx.x == 0) {
        const unsigned x = xb_xcc_id();
        __builtin_amdgcn_s_waitcnt(0);
        unsigned nloc = st[0], nx = st[1];
        if (nloc == 0u) { xcd_barrier_complete(bar, x, nloc, nx); st[0] = nloc; st[1] = nx; }
        const unsigned old = xb_add(&bar[XB_XSUB(x)], 1u);
        const unsigned gen = old / nloc;
        if (old + 1u == (gen + 1u) * nloc) {
            __builtin_amdgcn_fence(__ATOMIC_RELEASE, "agent");
            asm volatile("s_waitcnt vmcnt(0)" ::: "memory");
            const unsigned og = xb_add(&bar[XB_TOP], 1u);
            const unsigned tg = og / nx;
            if (og + 1u == (tg + 1u) * nx) xb_add(&bar[XB_TOPGEN], 1u);
            else XB_SPIN(xb_ld(&bar[XB_TOPGEN]) == tg, bar);
            __builtin_amdgcn_fence(__ATOMIC_ACQUIRE, "agent");
            xb_add(&bar[XB_XGEN(x)], 1u);
            asm volatile("s_waitcnt vmcnt(0)" ::: "memory");
        } else {
            XB_SPIN(xb_ld(&bar[XB_XGEN(x)]) == gen, bar);
            __builtin_amdgcn_fence(__ATOMIC_ACQUIRE, "agent");
            asm volatile("s_waitcnt vmcnt(0)" ::: "memory");
        }
    }
    __syncthreads();
}

#ifndef PPL
#define PPL 5
#endif
#ifndef NA_PROBE_SKIP
#define NA_PROBE_SKIP 0
#endif
constexpr int N_PHASES = 1 + PPL * DEPTH;
#ifndef REP0
#define REP0 1
#endif
#ifndef REPN
#define REPN 1
#endif
#ifndef REPS
#define REPS 1
#endif
#ifndef REP2
#define REP2 1
#endif
#ifndef REP3
#define REP3 1
#endif
#ifndef REPP
#define REPP 1
#endif
__global__ void __launch_bounds__(512, 2) fwd(Params p_, int ph_lo, int ph_hi) {
    extern __shared__ __attribute__((aligned(16))) unsigned char shm[];
    LAS unsigned char* lds = (LAS unsigned char*)shm;
    volatile LAS unsigned* xst = (volatile LAS unsigned*)(lds + 131072);
    if (threadIdx.x == 0) { xst[0] = 0u; xst[1] = 0u; }
    if (blockIdx.x == 0 && ph_lo == 0) { unsigned* bar0 = (unsigned*)(p_.ws + WS_BAR); for (int i = threadIdx.x; i < XCD_BAR_WORDS; i += 512) bar0[i] = 0u; }
    __syncthreads();
    for (int ph = ph_lo; ph < ph_hi; ++ph) {
        if (ph != ph_lo) {
            if (ph == 1) { cg::this_grid().sync(); if (threadIdx.x == 0) (void)xb_add(&((unsigned*)(p_.ws + WS_BAR))[XB_XCNT(xb_xcc_id())], 1u); }
            else { const __attribute__((address_space(4))) Params* pb = (const __attribute__((address_space(4))) Params*)__builtin_amdgcn_kernarg_segment_ptr(); xcd_barrier((unsigned*)(pb->ws + WS_BAR), xst); }
        }
        int tid = threadIdx.x; asm volatile("" : "+v"(tid));
        const __attribute__((address_space(4))) Params* pp = (const __attribute__((address_space(4))) Params*)__builtin_amdgcn_kernarg_segment_ptr(); asm volatile("" : "+s"(pp));
        Params p;
        p.x = pp->x; p.pre_g = pp->pre_g; p.post_g = pp->post_g; p.w_in = pp->w_in; p.rpb = pp->rpb; p.ln_g = pp->ln_g; p.ln_b = pp->ln_b; p.sg_w = pp->sg_w; p.sg_b = pp->sg_b;
        p.w_pa = pp->w_pa; p.w_pb = pp->w_pb; p.w_out = pp->w_out; p.out = pp->out; p.ws = pp->ws;
        bf16_t* H = (bf16_t*)(p.ws + WS_H); bf16_t* VT = (bf16_t*)(p.ws + WS_VT); bf16_t* PROJ = (bf16_t*)(p.ws + WS_PROJ);
        float* T1 = (float*)(p.ws + WS_PROJ);
        float* OUT = T1;
        if (ph == 0) { for (int rep = 0; rep < REPP; ++rep) { prologue(p, lds, tid); __syncthreads(); } continue; }
        const int layer = (ph - 1) / PPL, kk = (ph - 1) % PPL, k = (PPL == 6) ? (kk == 0 ? 0 : kk == 1 ? 5 : kk - 1) : kk;
        const unsigned char* wl = p.ws + WS_W + layer * SZ_LAYER_W;
        #if PPL == 6
        if (k == 5) { na_phase<NA_PROBE_SKIP>(p, layer, lds, tid); } else
#endif
        if (k == 1) { na_phase<0>(p, layer, lds, tid); if (k == 1) { sg_phase(p, layer, lds, tid); __syncthreads(); } }
        else if (k == 4) {
            post_rows(layer == 0 ? p.x : p.out, PROJ, p.post_g + layer * DM, p.out, (layer + 1 < DEPTH) ? p.pre_g + (layer + 1) * DM : nullptr, H, tid);
        } else {
            const int njobs = (k == 0) ? 2 : 1, reps = (k == 0) ? REP0 : (k == 2) ? REP2 : REP3;
            for (int jj = 0; jj < njobs * reps; ++jj) { const int j = jj % njobs;
                pg8::Gemm g; pg8::Epi E; E.obf = nullptr; E.ldo = 0; E.sigcol = 0x7fffffff; E.gate = nullptr; E.ldg = 0; E.kt = nullptr;
                if (k == 0 && j == 0) { g.A = H; g.lda = DM; g.Bt = (const bf16_t*)(wl + OFF_WIN); g.ldb = DM; g.M = NTOK; g.N = NP; g.K = DM; E.mode = 0; E.obf = PROJ; E.ldo = NP; E.sigcol = GA_OFF; E.kt = (bf16_t*)(p.ws + WS_KT); }
                else if (k == 0) { g.A = (const bf16_t*)(wl + OFF_WIN) + (size_t)NP * DM; g.lda = DM; g.Bt = H; g.ldb = DM; g.M = 2048; g.N = NTOK; g.K = DM; E.mode = 4; E.obf = VT; E.ldo = 0; }
                else if (k == 2) { g.A = H; g.lda = DM; g.Bt = (const bf16_t*)(wl + OFF_WPA); g.ldb = DM; g.M = NTOK; g.N = DM; g.K = DM; E.mode = 2; E.gate = PROJ + GA_OFF; E.ldg = NP; E.obf = VT; E.ldo = DM; }
                else { g.A = VT; g.lda = DM; g.Bt = (const bf16_t*)(wl + OFF_WOUT); g.ldb = DM; g.M = NTOK; g.N = DM; g.K = DM; E.mode = 0; E.obf = PROJ; E.ldo = DM; }
                pg8::StaticOrder S; S.init(g.M, g.N, (int)gridDim.x, (int)blockIdx.x);
                pg8::gemm_phase(lds, g, S, E, tid);
                __syncthreads();
            }
        }
    }
}

extern "C" void kernel_launch(void* const* d_in, const int* in_sizes, int n_in, void* d_out, int out_size, void* d_ws, size_t ws_size, hipStream_t stream) {
    static int grid = 0;
    if (!grid) {
        if (n_in != 12 || in_sizes[0] != NTOK * DM || out_size != NTOK * DM || ws_size < WS_END) {
            fprintf(stderr, "kernel_launch: unexpected shapes (n_in %d, in0 %d, out %d, ws %zu, need %zu)\n", n_in, n_in > 0 ? in_sizes[0] : -1, out_size, ws_size, (size_t)WS_END); return; }
        int dev = 0, cus = 0, per_cu = 0;
        (void)hipGetDevice(&dev); (void)hipDeviceGetAttribute(&cus, hipDeviceAttributeMultiprocessorCount, dev);
        (void)hipFuncSetAttribute((const void*)fwd, hipFuncAttributeMaxDynamicSharedMemorySize, LDS_BYTES);
        (void)hipOccupancyMaxActiveBlocksPerMultiprocessor(&per_cu, (const void*)fwd, 512, LDS_BYTES);
        if (per_cu < 1) { fprintf(stderr, "kernel_launch: occupancy query says %d blocks per CU\n", per_cu); per_cu = 1; }
        grid = cus * per_cu;
    }
    Params p{};
    p.x = (const float*)d_in[0]; p.pre_g = (const float*)d_in[1]; p.post_g = (const float*)d_in[2]; p.w_in = (const float*)d_in[3]; p.rpb = (const float*)d_in[4];
    p.ln_g = (const float*)d_in[5]; p.ln_b = (const float*)d_in[6]; p.sg_w = (const float*)d_in[7]; p.sg_b = (const float*)d_in[8];
    p.w_pa = (const float*)d_in[9]; p.w_pb = (const float*)d_in[10]; p.w_out = (const float*)d_in[11]; p.out = (float*)d_out; p.ws = (unsigned char*)d_ws;
#ifdef MULTI_LAUNCH
    for (int ph = 0; ph < N_PHASES; ++ph) hipLaunchKernelGGL(fwd, dim3(grid), dim3(512), LDS_BYTES, stream, p, ph, ph + 1);
#else
    int lo = 0, hi = N_PHASES;
    void* args[] = {&p, &lo, &hi};
    hipError_t e = hipLaunchCooperativeKernel((const void*)fwd, dim3(grid), dim3(512), args, LDS_BYTES, stream);
    if (e != hipSuccess) fprintf(stderr, "cooperative launch failed: %s (grid %d)\n", hipGetErrorString(e), grid);
#endif
}
```

```cpp
#include <hip/hip_runtime.h>
#include <hip/hip_cooperative_groups.h>
#include <cstdio>
#include <cstdint>
namespace cg = cooperative_groups;

#define LAS __attribute__((address_space(3)))
typedef unsigned short bf16_t;
typedef short bf16x8 __attribute__((ext_vector_type(8)));
typedef float f32x4 __attribute__((ext_vector_type(4)));
typedef unsigned u32x4 __attribute__((ext_vector_type(4)));
typedef unsigned u32x2 __attribute__((ext_vector_type(2)));

constexpr int DM = 2048, NTOK = 32768, SEQ = 16384, NIN = 11264, DEPTH = 2;
constexpr int NP = 9216;
constexpr int Q_OFF = 0, K_OFF = 1024, ZA_OFF = 2048, U_OFF = 3072, ZB_OFF = 4096, GA_OFF = 5120, GB_OFF = 7168;
constexpr int RPB_N = 8 * 15 * 31;
constexpr size_t SZ_WIN = (size_t)NIN * DM * 2, SZ_WP = (size_t)DM * 1024 * 2, SZ_WOUT = (size_t)DM * DM * 2, SZ_SGW = (size_t)8 * 128 * 128 * 2;
constexpr size_t OFF_WIN = 0, OFF_WPA = OFF_WIN + SZ_WIN, OFF_WPB = OFF_WPA + SZ_WP, OFF_WOUT = OFF_WPB + SZ_WP, OFF_SGW = OFF_WOUT + SZ_WOUT, SZ_LAYER_W = OFF_SGW + SZ_SGW;
constexpr size_t WS_W = 0, WS_H = WS_W + DEPTH * SZ_LAYER_W, WS_VT = WS_H + (size_t)NTOK * DM * 2, WS_PROJ = WS_VT + (size_t)2048 * NTOK * 2,
                 WS_BAR = WS_PROJ + (size_t)NTOK * NP * 2, WS_KT = WS_BAR + 16384, WS_END = WS_KT + (size_t)NTOK * 1024 * 2;
constexpr int LDS_BYTES = 131072 + 64;

struct Params {
    const float* x; const float* pre_g; const float* post_g; const float* w_in; const float* rpb; const float* ln_g; const float* ln_b;
    const float* sg_w; const float* sg_b; const float* w_pa; const float* w_pb; const float* w_out; float* out; unsigned char* ws;
};

__device__ __forceinline__ unsigned f2bf(float f) { unsigned u = __builtin_bit_cast(unsigned, f); return (u + 0x7fffu + ((u >> 16) & 1u)) >> 16; }
__device__ __forceinline__ unsigned cvt_pk_bf16(float lo, float hi) { unsigned r; asm volatile("v_cvt_pk_bf16_f32 %0, %1, %2" : "=v"(r) : "v"(lo), "v"(hi)); return r; }
__device__ __forceinline__ float bflo(unsigned w) { return __builtin_bit_cast(float, w << 16); }
__device__ __forceinline__ float bfhi(unsigned w) { return __builtin_bit_cast(float, w & 0xffff0000u); }
__device__ __forceinline__ float sigmoidf_(float v) { return __builtin_amdgcn_rcpf(1.0f + __expf(-v)); }
__device__ __forceinline__ float siluf_(float v) { return v * sigmoidf_(v); }

namespace pg8 {
constexpr int BM = 256, BK = 64, HALF = 128, HTB = HALF * BK * 2, STAGE_BYTES = 8 * HTB, NXCD = 8, WGM = 8;
__host__ __device__ __forceinline__ int lds_byte(int r, int c) { const int st = (r >> 4) * 2 + (c >> 5), rr = r & 15, cc = c & 31, ob = rr * 64 + cc * 2; return st * 1024 + (ob ^ (((ob >> 9) & 1) << 5)); }
__host__ __device__ __forceinline__ void stage_rc(int b, int& R, int& C) { const int st = b / 1024, sb = b % 1024, swz = sb ^ (((sb >> 9) & 1) << 5); R = (st >> 1) * 16 + swz / 64; C = (st & 1) * 32 + (swz % 64) / 2; }
__host__ __device__ __forceinline__ int perm32(int rho) { const int n = rho >> 4, i = rho & 15; return 8 * (i >> 2) + 4 * n + (i & 3); }

struct Unit { int pm, pn; };
struct Gemm { const bf16_t* A; const bf16_t* Bt; int M, N, K, lda, ldb; };

struct StaticOrder {
    int nM, nN, nwg, G, c;
    __device__ void init(int M, int N, int G_, int c_) { nM = M / BM; nN = N / BM; nwg = nM * nN; G = G_; c = c_; }
    __device__ bool next(int i, Unit& u) const {
        const long L = (long)i * G + c; if (L >= nwg) return false;
        int wgid = (int)L; { const int q = nwg / NXCD, r = nwg % NXCD, xcd = wgid % NXCD, off = wgid / NXCD; wgid = (xcd < r ? xcd * (q + 1) : r * (q + 1) + (xcd - r) * q) + off; }
        const int nig = WGM * nN, gid = wgid / nig, fm = gid * WGM, gsz = (nM - fm) < WGM ? (nM - fm) : WGM;
        u.pm = fm + ((wgid % nig) % gsz); u.pn = (wgid % nig) / gsz; return true;
    }
};

struct Epi {
    int mode;
    bf16_t* obf; int ldo;
    int sigcol;
    bf16_t* kt;
    const bf16_t* gate; int ldg;
    __device__ __forceinline__ void operator()(const f32x4 (&acc)[2][2][4][2], const Unit& u, int wr, int wc, int fr, int fq) const {
        const int row0 = u.pm * BM + wr * 64 + fr, col0 = u.pn * BM + wc * 32 + 8 * fq;
        if (mode == 2) {
#pragma unroll
            for (int ai = 0; ai < 2; ++ai) {
                u32x4 GB[4][2];
#pragma unroll
                for (int m = 0; m < 4; ++m)
#pragma unroll
                    for (int bj = 0; bj < 2; ++bj) GB[m][bj] = *(const u32x4*)(gate + (size_t)(row0 + ai * HALF + m * 16) * ldg + col0 + bj * HALF + 2048);
                __builtin_amdgcn_sched_barrier(0);
#pragma unroll
                for (int m = 0; m < 4; ++m)
#pragma unroll
                    for (int bj = 0; bj < 2; ++bj) {
                        const u32x4 g = GB[m][bj]; f32x4 v0 = acc[ai][bj][m][0], v1 = acc[ai][bj][m][1];
                        v0[0] *= bflo(g.x); v0[1] *= bfhi(g.x); v0[2] *= bflo(g.y); v0[3] *= bfhi(g.y); v1[0] *= bflo(g.z); v1[1] *= bfhi(g.z); v1[2] *= bflo(g.w); v1[3] *= bfhi(g.w);
                        u32x4 w; w.x = cvt_pk_bf16(v0[0], v0[1]); w.y = cvt_pk_bf16(v0[2], v0[3]); w.z = cvt_pk_bf16(v1[0], v1[1]); w.w = cvt_pk_bf16(v1[2], v1[3]);
                        *(u32x4*)(obf + (size_t)(row0 + ai * HALF + m * 16) * ldo + col0 + bj * HALF) = w;
                    }
                __builtin_amdgcn_sched_barrier(0);
            }
            return;
        }
        if ((mode == 0) && (u.pn * BM >= sigcol)) {
            const int c0 = sigcol + (u.pn - sigcol / BM) * HALF + wc * 32 + 8 * fq;
#pragma unroll
            for (int ai = 0; ai < 2; ++ai)
#pragma unroll
                for (int m = 0; m < 4; ++m) {
                    const size_t row = (size_t)(row0 + ai * HALF + m * 16);
                    float rr[8], sb[8];
#pragma unroll
                    for (int e = 0; e < 8; ++e) { const float ga = acc[ai][0][m][e >> 2][e & 3], gb = acc[ai][1][m][e >> 2][e & 3];
                        const float eb = 1.0f + __expf(-gb); sb[e] = __builtin_amdgcn_rcpf(eb); rr[e] = eb * __builtin_amdgcn_rcpf(1.0f + __expf(-ga)); }
                    u32x4 w; w.x = cvt_pk_bf16(rr[0], rr[1]); w.y = cvt_pk_bf16(rr[2], rr[3]); w.z = cvt_pk_bf16(rr[4], rr[5]); w.w = cvt_pk_bf16(rr[6], rr[7]);
                    *(u32x4*)(obf + row * ldo + c0) = w;
                    w.x = cvt_pk_bf16(sb[0], sb[1]); w.y = cvt_pk_bf16(sb[2], sb[3]); w.z = cvt_pk_bf16(sb[4], sb[5]); w.w = cvt_pk_bf16(sb[6], sb[7]);
                    *(u32x4*)(obf + row * ldo + c0 + 2048) = w;
                }
            return;
        }
        const bool sg = false;
        const bool ktile = (mode == 0) && (kt != nullptr) && (u.pn >= 4) && (u.pn < 8);
#pragma unroll
        for (int ai = 0; ai < 2; ++ai)
#pragma unroll
            for (int m = 0; m < 4; ++m) {
                const size_t row = (size_t)(row0 + ai * HALF + m * 16);
#pragma unroll
                for (int bj = 0; bj < 2; ++bj) {
                    const int col = col0 + bj * HALF;
                    f32x4 v0 = acc[ai][bj][m][0], v1 = acc[ai][bj][m][1];
                    if (sg) {
#pragma unroll
                        for (int e = 0; e < 4; ++e) { v0[e] = sigmoidf_(v0[e]); v1[e] = sigmoidf_(v1[e]); }
                    }
                    u32x4 w; w.x = cvt_pk_bf16(v0[0], v0[1]); w.y = cvt_pk_bf16(v0[2], v0[3]); w.z = cvt_pk_bf16(v1[0], v1[1]); w.w = cvt_pk_bf16(v1[2], v1[3]);
                    if (ktile) __builtin_nontemporal_store(w, (u32x4*)(kt + (((row >> 6) * 8 + (size_t)((u.pn - 4) * 2 + bj)) * 64 + (row & 63)) * 128 + (wc * 32 + 8 * fq)));
                    else if (mode == 0) { if (kt != nullptr) __builtin_nontemporal_store(w, (u32x4*)(obf + row * ldo + col)); else *(u32x4*)(obf + row * ldo + col) = w; }
                    else *(u32x4*)(obf + ((size_t)(col >> 6) * 2048 + row) * 64 + (col & 63)) = w;
                }
            }
    }
    __device__ __forceinline__ void mid(f32x4 (&acc)[2][2][4][2], const Unit& u, int wr, int wc, int fr, int fq) const {
        int row0 = u.pm * BM + wr * 64 + fr, col0 = u.pn * BM + wc * 32 + 8 * fq;
        asm volatile("" : "+v"(row0), "+v"(col0));
        u32x4 RT[2][4][2];
#pragma unroll
        for (int ai = 0; ai < 2; ++ai)
#pragma unroll
            for (int m = 0; m < 4; ++m)
#pragma unroll
                for (int bj = 0; bj < 2; ++bj) RT[ai][m][bj] = *(const u32x4*)(gate + (size_t)(row0 + ai * HALF + m * 16) * ldg + col0 + bj * HALF);
        __builtin_amdgcn_sched_barrier(0);
#pragma unroll
        for (int ai = 0; ai < 2; ++ai)
#pragma unroll
            for (int m = 0; m < 4; ++m)
#pragma unroll
                for (int bj = 0; bj < 2; ++bj) {
                    const unsigned rw[4] = {RT[ai][m][bj].x, RT[ai][m][bj].y, RT[ai][m][bj].z, RT[ai][m][bj].w};
#pragma unroll
                    for (int i = 0; i < 4; ++i) { acc[ai][bj][m][i >> 1][(i & 1) * 2] *= bflo(rw[i]); acc[ai][bj][m][i >> 1][(i & 1) * 2 + 1] *= bfhi(rw[i]); }
                }
        __builtin_amdgcn_sched_barrier(0);
    }
};

__device__ __forceinline__ void gemm_phase(LAS unsigned char* lds, const Gemm g, const StaticOrder& S, const Epi& E, const int tid) {
    const int wid = __builtin_amdgcn_readfirstlane(tid >> 6), lane = tid & 63, wr = wid >> 2, wc = wid & 3, fr = lane & 15, fq = lane >> 4;
    const int K = g.K, nt = K / BK;
    unsigned voffA[2], voffB[2];
#pragma unroll
    for (int i = 0; i < 2; ++i) { int R, C; stage_rc(tid * 16 + i * 8192, R, C); const int Rb = (R & ~31) + perm32(R & 31);
        voffA[i] = (unsigned)(R * g.lda + C) * 2u; voffB[i] = (unsigned)(Rb * g.ldb + C) * 2u; }
    const size_t kstep = (size_t)(BK * 2);
    const size_t hstepA = (size_t)HALF * g.lda * 2, hstepB = (size_t)HALF * g.ldb * 2;
    const size_t tstepA = 2 * hstepA, tstepB = 2 * hstepB;
    const unsigned ldsw = (unsigned)wid * 1024u;
    const int aoff = lds_byte(wr * 64 + fr, fq * 8), boff = lds_byte(wc * 32 + fr, fq * 8);
#define PG8_SA(b, h) (((b) * 2 + (h)) * HTB)
#define PG8_SB(b, h) ((4 + (b) * 2 + (h)) * HTB)
#define PG8_STAGE(bufoff, gbase, voff) do { _Pragma("unroll") for (int _i = 0; _i < 2; ++_i) \
        __builtin_amdgcn_global_load_lds((const unsigned*)((const char*)(gbase) + (voff)[_i]), (LAS unsigned*)(lds + (bufoff) + ldsw + _i * 8192), 16, 0, 0); } while (0)
#define PG8_LDA(dst, b, h) do { _Pragma("unroll") for (int m = 0; m < 4; ++m) _Pragma("unroll") for (int k = 0; k < 2; ++k) dst[m][k] = *(const LAS bf16x8*)(lds + PG8_SA(b, h) + aoff + m * 2048 + k * 1024); } while (0)
#define PG8_LDB(dst, b, h) do { _Pragma("unroll") for (int n = 0; n < 2; ++n) _Pragma("unroll") for (int k = 0; k < 2; ++k) dst[n][k] = *(const LAS bf16x8*)(lds + PG8_SB(b, h) + boff + n * 2048 + k * 1024); } while (0)
#define PG8_MMA(ai, bj, At, Bt) do { __builtin_amdgcn_s_setprio(1); _Pragma("unroll") for (int m = 0; m < 4; ++m) _Pragma("unroll") for (int n = 0; n < 2; ++n) _Pragma("unroll") for (int k = 0; k < 2; ++k) \
        acc[ai][bj][m][n] = __builtin_amdgcn_mfma_f32_16x16x32_bf16(Bt[n][k], At[m][k], acc[ai][bj][m][n], 0, 0, 0); __builtin_amdgcn_s_setprio(0); } while (0)
#define PG8_WAIT_V(n) asm volatile("s_waitcnt vmcnt(" #n ")" ::: "memory")
#define PG8_WAIT_L(n) asm volatile("s_waitcnt lgkmcnt(" #n ")" ::: "memory")
#define PG8_BAR __builtin_amdgcn_s_barrier()
#define PG8_SCHED __builtin_amdgcn_sched_barrier(0)
    Unit cur, nxt; int ui = 0;
    if (!S.next(0, cur)) return;
    f32x4 acc[2][2][4][2];
#pragma unroll
    for (int a = 0; a < 2; ++a)
#pragma unroll
        for (int b = 0; b < 2; ++b)
#pragma unroll
            for (int m = 0; m < 4; ++m)
#pragma unroll
                for (int n = 0; n < 2; ++n) acc[a][b][m][n] = (f32x4){0.f, 0.f, 0.f, 0.f};
    bf16x8 At[4][2], B0[2][2], B1[2][2];
    const char* cA = (const char*)g.A + (size_t)cur.pm * tstepA; const char* cB = (const char*)g.Bt + (size_t)cur.pn * tstepB;
    PG8_STAGE(PG8_SB(0, 0), cB, voffB); PG8_STAGE(PG8_SB(0, 1), cB + hstepB, voffB); PG8_STAGE(PG8_SA(0, 0), cA, voffA); PG8_STAGE(PG8_SA(0, 1), cA + hstepA, voffA);
    if (wr == 1) PG8_BAR;
    PG8_WAIT_V(2); PG8_BAR;
    PG8_STAGE(PG8_SB(1, 0), cB + kstep, voffB); PG8_STAGE(PG8_SA(1, 0), cA + kstep, voffA); PG8_STAGE(PG8_SB(1, 1), cB + hstepB + kstep, voffB);
    PG8_WAIT_V(6); PG8_BAR;
    for (;;) {
        const bool has_next = S.next(ui + 1, nxt);
        const char* nA = has_next ? (const char*)g.A + (size_t)nxt.pm * tstepA : cA; const char* nB = has_next ? (const char*)g.Bt + (size_t)nxt.pn * tstepB : cB;
        for (int t = 0; t < nt; t += 2) {
            if (E.mode == 2 && t == (nt >> 1)) E.mid(acc, cur, wr, wc, fr, fq);
            const bool last = (t == nt - 2);
            const char* a1 = cA + (size_t)(t + 1) * kstep;
            const char* a2 = last ? nA : cA + (size_t)(t + 2) * kstep; const char* b2 = last ? nB : cB + (size_t)(t + 2) * kstep;
            const char* a3 = a2 + kstep; const char* b3 = b2 + kstep;
            PG8_LDB(B0, 0, 0); PG8_LDB(B1, 0, 1); PG8_SCHED; PG8_LDA(At, 0, 0); PG8_STAGE(PG8_SA(1, 1), a1 + hstepA, voffA);
            PG8_WAIT_V(8); PG8_WAIT_L(0); PG8_BAR; PG8_MMA(0, 0, At, B0); PG8_MMA(0, 1, At, B1); PG8_BAR; PG8_SCHED;
            PG8_LDA(At, 0, 1); PG8_STAGE(PG8_SB(0, 0), b2, voffB); PG8_STAGE(PG8_SB(0, 1), b2 + hstepB, voffB); PG8_STAGE(PG8_SA(0, 0), a2, voffA);
            PG8_WAIT_V(8); PG8_WAIT_L(0); PG8_BAR; PG8_MMA(1, 0, At, B0); PG8_MMA(1, 1, At, B1); PG8_BAR; PG8_SCHED;
            PG8_LDB(B0, 1, 0); PG8_LDB(B1, 1, 1); PG8_SCHED; PG8_LDA(At, 1, 0); PG8_STAGE(PG8_SA(0, 1), a2 + hstepA, voffA);
            PG8_WAIT_V(8); PG8_WAIT_L(0); PG8_BAR; PG8_MMA(0, 0, At, B0); PG8_MMA(0, 1, At, B1); PG8_BAR; PG8_SCHED;
            PG8_LDA(At, 1, 1); PG8_STAGE(PG8_SB(1, 0), b3, voffB); PG8_STAGE(PG8_SB(1, 1), b3 + hstepB, voffB); PG8_STAGE(PG8_SA(1, 0), a3, voffA);
            PG8_WAIT_V(8); PG8_WAIT_L(0); PG8_BAR; PG8_MMA(1, 0, At, B0); PG8_MMA(1, 1, At, B1); PG8_BAR; PG8_SCHED;
        }
        if (wr == 0) PG8_BAR;
        E(acc, cur, wr, wc, fr, fq);
#ifdef EPI2
        __builtin_amdgcn_sched_barrier(0); E(acc, cur, wr, wc, fr, fq);
#endif
        if (!has_next) break;
#pragma unroll
        for (int a = 0; a < 2; ++a)
#pragma unroll
            for (int b = 0; b < 2; ++b)
#pragma unroll
                for (int m = 0; m < 4; ++m)
#pragma unroll
                    for (int n = 0; n < 2; ++n) acc[a][b][m][n] = (f32x4){0.f, 0.f, 0.f, 0.f};
        cur = nxt; cA = nA; cB = nB; ++ui;
        if (wr == 1) PG8_BAR;
    }
    PG8_WAIT_V(0);
    PG8_BAR;
#undef PG8_SA
#undef PG8_SB
#undef PG8_STAGE
#undef PG8_LDA
#undef PG8_LDB
#undef PG8_MMA
#undef PG8_WAIT_V
#undef PG8_WAIT_L
#undef PG8_BAR
#undef PG8_SCHED
}
}

__device__ __forceinline__ void convert_tile(const float* W, bf16_t* Wt, int K, int N, int k0, int n0, int orow0, LAS bf16_t* tl, const int tid, int ldw, int kofs) {
    { const int kk = tid >> 4, n4 = (tid & 15) * 4;
#pragma unroll
      for (int h = 0; h < 2; ++h) { const int k = kk + 32 * h; const f32x4 v = *(const f32x4*)(W + (size_t)(k0 + k) * N + n0 + n4);
#pragma unroll
          for (int e = 0; e < 4; ++e) tl[(n4 + e) * 72 + k] = (bf16_t)f2bf(v[e]); } }
    __syncthreads();
    { const int n = tid >> 3, ks = (tid & 7) * 8; const u32x4 w = *(const LAS u32x4*)(tl + n * 72 + ks);
      *(u32x4*)(Wt + (size_t)(orow0 + n) * ldw + kofs + k0 + ks) = w; }
    __syncthreads();
}
__device__ __forceinline__ int win_row(int n0) {
    const int seg = n0 >> 10, r = n0 & 1023;
    switch (seg) { case 0: return r; case 1: return 1024 + r; case 2: return 9216 + r; case 3: return 2048 + r; case 4: return 3072 + r; case 5: return 10240 + r; case 6: return 4096 + r;
                   case 7: case 8: { const int c = n0 - 7168; return 5120 + (c >> 7) * 256 + (c & 127); }
                   default: { const int c = n0 - 9216; return 5120 + (c >> 7) * 256 + 128 + (c & 127); } }
}

__device__ __forceinline__ void rms_rows(const float* x, const float* g, bf16_t* H, const int tid) {
    const int wid = tid >> 6, lane = tid & 63, step = gridDim.x * 8;
    int row = blockIdx.x * 8 + wid;
    f32x4 v[8], vn[8], gg[8];
#pragma unroll
    for (int i = 0; i < 8; ++i) gg[i] = *(const f32x4*)(g + i * 256 + lane * 4);
    if (row < NTOK) {
#pragma unroll
        for (int i = 0; i < 8; ++i) v[i] = *(const f32x4*)(x + (size_t)row * DM + i * 256 + lane * 4); }
    for (; row < NTOK; row += step) {
        const int nrow = row + step;
        if (nrow < NTOK) {
#pragma unroll
            for (int i = 0; i < 8; ++i) vn[i] = *(const f32x4*)(x + (size_t)nrow * DM + i * 256 + lane * 4); }
        float ss = 0.f;
#pragma unroll
        for (int i = 0; i < 8; ++i) ss += v[i][0] * v[i][0] + v[i][1] * v[i][1] + v[i][2] * v[i][2] + v[i][3] * v[i][3];
#pragma unroll
        for (int o = 32; o > 0; o >>= 1) ss += __shfl_xor(ss, o);
        const float rstd = __builtin_amdgcn_rsqf(ss * (1.0f / DM) + 1e-6f);
#pragma unroll
        for (int i = 0; i < 8; ++i) {
            u32x2 w; w.x = cvt_pk_bf16(v[i][0] * rstd * gg[i][0], v[i][1] * rstd * gg[i][1]); w.y = cvt_pk_bf16(v[i][2] * rstd * gg[i][2], v[i][3] * rstd * gg[i][3]);
            *(u32x2*)(H + (size_t)row * DM + i * 256 + lane * 4) = w; }
#pragma unroll
        for (int i = 0; i < 8; ++i) v[i] = vn[i];
    }
}

__device__ __forceinline__ void post_rows(const float* xin, const bf16_t* OUT, const float* pg, float* out, const float* ng, bf16_t* H, const int tid) {
    const int wid = tid >> 6, lane = tid & 63, step = gridDim.x * 8;
    int row = blockIdx.x * 8 + wid;
    u32x2 ow[8], own[8]; f32x4 xw[8], xwn[8], pgv[8], ngv[8];
#pragma unroll
    for (int i = 0; i < 8; ++i) { pgv[i] = *(const f32x4*)(pg + i * 256 + lane * 4); ngv[i] = ng ? *(const f32x4*)(ng + i * 256 + lane * 4) : (f32x4){0.f, 0.f, 0.f, 0.f}; }
    if (row < NTOK) {
#pragma unroll
        for (int i = 0; i < 8; ++i) { ow[i] = *(const u32x2*)(OUT + (size_t)row * DM + i * 256 + lane * 4); xw[i] = *(const f32x4*)(xin + (size_t)row * DM + i * 256 + lane * 4); } }
    for (; row < NTOK; row += step) {
        const int nrow = row + step;
        if (nrow < NTOK) {
#pragma unroll
            for (int i = 0; i < 8; ++i) { own[i] = *(const u32x2*)(OUT + (size_t)nrow * DM + i * 256 + lane * 4); xwn[i] = *(const f32x4*)(xin + (size_t)nrow * DM + i * 256 + lane * 4); } }
        f32x4 o[8]; float ss = 0.f;
#pragma unroll
        for (int i = 0; i < 8; ++i) { const u32x2 w = ow[i];
            o[i][0] = bflo(w.x); o[i][1] = bfhi(w.x); o[i][2] = bflo(w.y); o[i][3] = bfhi(w.y); ss += o[i][0] * o[i][0] + o[i][1] * o[i][1] + o[i][2] * o[i][2] + o[i][3] * o[i][3]; }
#pragma unroll
        for (int s = 32; s > 0; s >>= 1) ss += __shfl_xor(ss, s);
        const float rstd = __builtin_amdgcn_rsqf(ss * (1.0f / DM) + 1e-6f);
        float s2 = 0.f;
#pragma unroll
        for (int i = 0; i < 8; ++i) { const f32x4 gg = pgv[i]; const f32x4 xv = xw[i];
            f32x4 r; r[0] = xv[0] + o[i][0] * rstd * gg[0]; r[1] = xv[1] + o[i][1] * rstd * gg[1]; r[2] = xv[2] + o[i][2] * rstd * gg[2]; r[3] = xv[3] + o[i][3] * rstd * gg[3];
            *(f32x4*)(out + (size_t)row * DM + i * 256 + lane * 4) = r; o[i] = r; s2 += r[0] * r[0] + r[1] * r[1] + r[2] * r[2] + r[3] * r[3]; }
        if (ng) {
#pragma unroll
            for (int s = 32; s > 0; s >>= 1) s2 += __shfl_xor(s2, s);
            const float rs2 = __builtin_amdgcn_rsqf(s2 * (1.0f / DM) + 1e-6f);
#pragma unroll
            for (int i = 0; i < 8; ++i) { const f32x4 gg = ngv[i];
                u32x2 w; w.x = cvt_pk_bf16(o[i][0] * rs2 * gg[0], o[i][1] * rs2 * gg[1]); w.y = cvt_pk_bf16(o[i][2] * rs2 * gg[2], o[i][3] * rs2 * gg[3]);
                *(u32x2*)(H + (size_t)row * DM + i * 256 + lane * 4) = w; }
        }
#pragma unroll
        for (int i = 0; i < 8; ++i) { ow[i] = own[i]; xw[i] = xwn[i]; }
    }
}

constexpr int NA_SLOT = 18432;
constexpr int NA_RPB_OFF = 3 * NA_SLOT;
#define NA_BAR() do { asm volatile("s_waitcnt lgkmcnt(0)" ::: "memory"); __builtin_amdgcn_s_barrier(); asm volatile("" ::: "memory"); } while (0)

struct NaUnit { int b, r0, head, rsA, delta; };
__device__ __forceinline__ NaUnit na_decode(int u) {
    NaUnit n; const int cc = u & 255, idx = cc >> 3; n.head = u >> 8; n.b = idx >> 4; n.r0 = 2 * ((cc & 7) * 16 + (idx & 15));
    n.rsA = min(max(n.r0 - 4, 0), 248); n.delta = min(max(n.r0 - 3, 0), 248) - n.rsA; return n; }

template <int I> __device__ __forceinline__ void na_issue(u32x4 (&R)[2], const bf16_t* KT, const bf16_t* VT, const NaUnit& n, const int tid) {
    if constexpr (I < 9) {
        const int row = min(n.rsA + I, 255);
        const bf16_t* base = KT + ((size_t)((n.b * 256 + row) * 8 + n.head)) * 8192 + tid * 8;
        R[0] = *(const u32x4*)base; R[1] = *(const u32x4*)(base + 4096);
    } else {
        const int row = min(n.rsA + (I - 9), 255);
        const bf16_t* base = VT + ((size_t)((n.b * 256 + row) * 2048 + n.head * 128)) * 64 + tid * 8;
        R[0] = *(const u32x4*)base; R[1] = *(const u32x4*)(base + 4096);
    }
}
template <int I> __device__ __forceinline__ void na_write(const u32x4 (&R)[2], LAS unsigned char* ring, const int tid) {
    LAS unsigned char* slot = ring + (I % 3) * NA_SLOT;
    if constexpr (I < 9) { LAS unsigned char* d = slot + (tid >> 4) * 288 + (tid & 15) * 16; *(LAS u32x4*)d = R[0]; *(LAS u32x4*)(d + 32 * 288) = R[1]; }
    else { LAS unsigned char* d = slot + (tid >> 3) * 144 + (tid & 7) * 16; *(LAS u32x4*)d = R[0]; *(LAS u32x4*)(d + 64 * 144) = R[1]; }
}

struct NaState { f32x4 s[8][2]; bf16x8 pf[8]; f32x4 o[8]; bf16x8 qf[4]; u32x2 z[8]; float inv; int idx[4]; bool sel[4]; unsigned m01, m23; };

template <int T> __device__ __forceinline__ void na_kstep(NaState& st, const LAS unsigned char* ring, int shift, int kc0, int fr, int fq) {
    const LAS unsigned char* base = ring + ((T + shift) % 3) * NA_SLOT + (kc0 + fr) * 288 + fq * 16;
    bf16x8 kf[2][4];
#pragma unroll
    for (int ct = 0; ct < 2; ++ct)
#pragma unroll
        for (int ks = 0; ks < 4; ++ks) kf[ct][ks] = *(const LAS bf16x8*)(base + ct * 16 * 288 + ks * 64);
    __builtin_amdgcn_sched_barrier(0);
    f32x4 a0 = {0.f, 0.f, 0.f, 0.f}, a1 = {0.f, 0.f, 0.f, 0.f};
#pragma unroll
    for (int ks = 0; ks < 4; ++ks) { a0 = __builtin_amdgcn_mfma_f32_16x16x32_bf16(kf[0][ks], st.qf[ks], a0, 0, 0, 0); a1 = __builtin_amdgcn_mfma_f32_16x16x32_bf16(kf[1][ks], st.qf[ks], a1, 0, 0, 0); }
    st.s[T][0] = a0; st.s[T][1] = a1;
}
template <int T> __device__ __forceinline__ void na_vstep(NaState& st, const LAS unsigned char* ring, int shift, int kc0, int fr, int fq) {
    const LAS unsigned char* vp = ring + ((9 + T + shift) % 3) * NA_SLOT + fr * 144 + (kc0 + 4 * fq) * 2;
    unsigned vph = (unsigned)(size_t)vp + 32u; asm volatile("" : "+v"(vph));
    const LAS unsigned char* vp2 = (const LAS unsigned char*)(size_t)vph;
    u32x2 lo[8], hi[8];
#pragma unroll
    for (int dt = 0; dt < 8; ++dt) { lo[dt] = *(const LAS u32x2*)(vp + dt * 16 * 144); hi[dt] = *(const LAS u32x2*)(vp2 + dt * 16 * 144); }
    __builtin_amdgcn_sched_barrier(0);
#pragma unroll
    for (int dt = 0; dt < 8; ++dt) {
        u32x4 w; w.x = lo[dt].x; w.y = lo[dt].y; w.z = hi[dt].x; w.w = hi[dt].y;
        st.o[dt] = __builtin_amdgcn_mfma_f32_16x16x32_bf16(__builtin_bit_cast(bf16x8, w), st.pf[T], st.o[dt], 0, 0, 0);
    }
}
__device__ __forceinline__ void na_softmax(NaState& st, const LAS float* rp, int head, int drow0) {
    const float scale2 = 0.08838834764831845f * 1.4426950408889634f;
    float mx = -1e30f;
#pragma unroll
    for (int ki = 0; ki < 8; ++ki) {
        const LAS float* row = rp + (head * 15 + drow0 + ki) * 32;
#pragma unroll
        for (int j = 0; j < 4; ++j) { const float sv = st.sel[j] ? st.s[ki][0][j] : st.s[ki][1][j]; const float v = __builtin_fmaf(sv, scale2, row[st.idx[j]]); st.s[ki][0][j] = v; mx = fmaxf(mx, v); }
    }
    mx = fmaxf(mx, __shfl_xor(mx, 16)); mx = fmaxf(mx, __shfl_xor(mx, 32));
    float sum = 0.f;
    const unsigned m01 = st.m01, m23 = st.m23;
#pragma unroll
    for (int ki = 0; ki < 8; ++ki) {
        float e[4];
#pragma unroll
        for (int j = 0; j < 4; ++j) { e[j] = __builtin_amdgcn_exp2f(st.s[ki][0][j] - mx); sum += e[j]; }
        const unsigned p01 = cvt_pk_bf16(e[0], e[1]), p23 = cvt_pk_bf16(e[2], e[3]);
        u32x4 w; w.x = p01 & m01; w.y = p23 & m23; w.z = p01 & ~m01; w.w = p23 & ~m23;
        st.pf[ki] = __builtin_bit_cast(bf16x8, w);
    }
    sum += __shfl_xor(sum, 16); sum += __shfl_xor(sum, 32);
    st.inv = 1.0f / sum;
#pragma unroll
    for (int dt = 0; dt < 8; ++dt) st.o[dt] = (f32x4){0.f, 0.f, 0.f, 0.f};
}

template <int skip> __device__ __forceinline__ void na_phase(const Params& p, int layer, LAS unsigned char* lds, const int tid) {
    LAS float* rp = (LAS float*)(lds + NA_RPB_OFF);
    for (int i = tid; i < 8 * 15 * 32; i += 512) { const int rw = i >> 5, cl = i & 31; rp[i] = (cl < 31) ? p.rpb[layer * RPB_N + rw * 31 + cl] * 1.4426950408889634f : -1e30f; }
    const bf16_t* PROJ = (const bf16_t*)(p.ws + WS_PROJ); const bf16_t* VT = (const bf16_t*)(p.ws + WS_VT); bf16_t* Y = (bf16_t*)(p.ws + WS_H); const bf16_t* KT = (const bf16_t*)(p.ws + WS_KT);
    const int wid = __builtin_amdgcn_readfirstlane(tid >> 6), lane = tid & 63, fr = lane & 15, fq = lane >> 4, ri = wid >> 2, qb = wid & 3;
    const int kc0 = (qb == 0) ? 0 : (qb == 1) ? 8 : (qb == 2) ? 24 : 32, qcol = 16 * qb + fr;
    const int G = (int)gridDim.x, c = (int)blockIdx.x;
    if (c >= 2048) { __syncthreads(); return; }
    LAS unsigned char* ring = lds;
    NaState st; u32x4 R0[2], R1[2], R2[2], R3[2], R4[2], R5[2];
    { const int cs = min(max(qcol - 8, 0), 48); unsigned m01 = 0u, m23 = 0u;
#pragma unroll
      for (int j = 0; j < 4; ++j) { const int k0 = kc0 + 4 * fq + j; const bool v0 = (k0 >= cs) && (k0 < cs + 16);
          st.sel[j] = v0; st.idx[j] = (v0 ? k0 : k0 + 16) - qcol + 15;
          if (v0) { if (j == 0) m01 |= 0xffffu; if (j == 1) m01 |= 0xffff0000u; if (j == 2) m23 |= 0xffffu; if (j == 3) m23 |= 0xffff0000u; } }
      st.m01 = m01; st.m23 = m23; }
    NaUnit cur = na_decode(c);
    na_issue<0>(R0, KT, VT, cur, tid); na_issue<1>(R1, KT, VT, cur, tid); na_issue<2>(R2, KT, VT, cur, tid);
    na_issue<3>(R3, KT, VT, cur, tid); na_issue<4>(R4, KT, VT, cur, tid); na_issue<5>(R5, KT, VT, cur, tid);
    { const size_t qtok = (size_t)(cur.b * SEQ + (cur.r0 + ri) * 64 + qcol);
#pragma unroll
      for (int ks = 0; ks < 4; ++ks) st.qf[ks] = *(const bf16x8*)(PROJ + qtok * NP + Q_OFF + cur.head * 128 + ks * 32 + fq * 8); }
    for (int u = c; u < 2048; u += G) {
        const bool has_next = (u + G) < 2048;
        const NaUnit nxt = has_next ? na_decode(u + G) : cur;
        const int my_r = cur.r0 + ri, shift = ri ? cur.delta : 0, head = cur.head;
        const size_t qtok = (size_t)(cur.b * SEQ + my_r * 64 + qcol);
#define NA_PUT(I, RR, NU, NI) do { if constexpr (!(skip & 8)) { na_write<I>(RR, ring, tid); na_issue<NI>(RR, KT, VT, NU, tid); } } while (0)
        NA_BAR();
        NA_PUT(0, R0, cur, 6); NA_PUT(1, R1, cur, 7);   NA_BAR(); if constexpr (!(skip & 1)) na_kstep<0>(st, ring, shift, kc0, fr, fq);
        NA_PUT(2, R2, cur, 8);                          NA_BAR(); if constexpr (!(skip & 1)) na_kstep<1>(st, ring, shift, kc0, fr, fq);
        NA_PUT(3, R3, cur, 9);                          NA_BAR(); if constexpr (!(skip & 1)) na_kstep<2>(st, ring, shift, kc0, fr, fq);
        NA_PUT(4, R4, cur, 10);                          NA_BAR(); if constexpr (!(skip & 1)) na_kstep<3>(st, ring, shift, kc0, fr, fq);
        NA_PUT(5, R5, cur, 11);                          NA_BAR(); if constexpr (!(skip & 1)) na_kstep<4>(st, ring, shift, kc0, fr, fq);
        NA_PUT(6, R0, cur, 12);                          NA_BAR(); if constexpr (!(skip & 1)) na_kstep<5>(st, ring, shift, kc0, fr, fq);
        NA_PUT(7, R1, cur, 13);                         NA_BAR(); if constexpr (!(skip & 1)) na_kstep<6>(st, ring, shift, kc0, fr, fq);
        NA_PUT(8, R2, cur, 14);                         NA_BAR(); if constexpr (!(skip & 1)) na_kstep<7>(st, ring, shift, kc0, fr, fq);
        if constexpr (!(skip & 2)) na_softmax(st, rp, head, (cur.rsA + shift) - my_r + 7);
        if constexpr (!(skip & 4)) {
#pragma unroll
        for (int dt = 0; dt < 8; ++dt) st.z[dt] = *(const u32x2*)(PROJ + qtok * NP + ZA_OFF + head * 128 + dt * 16 + 4 * fq); }
        NA_BAR();
        NA_PUT(9, R3, cur, 15); NA_PUT(10, R4, cur, 16); NA_BAR(); if constexpr (!(skip & 1)) na_vstep<0>(st, ring, shift, kc0, fr, fq);
        NA_PUT(11, R5, cur, 17);                         NA_BAR(); if constexpr (!(skip & 1)) na_vstep<1>(st, ring, shift, kc0, fr, fq);
        NA_PUT(12, R0, nxt, 0);                         NA_BAR(); if constexpr (!(skip & 1)) na_vstep<2>(st, ring, shift, kc0, fr, fq);
        NA_PUT(13, R1, nxt, 1);                         NA_BAR(); if constexpr (!(skip & 1)) na_vstep<3>(st, ring, shift, kc0, fr, fq);
        NA_PUT(14, R2, nxt, 2);                         NA_BAR(); if constexpr (!(skip & 1)) na_vstep<4>(st, ring, shift, kc0, fr, fq);
        { const size_t nq = (size_t)(nxt.b * SEQ + (nxt.r0 + ri) * 64 + qcol);
#pragma unroll
          for (int ks = 0; ks < 4; ++ks) st.qf[ks] = *(const bf16x8*)(PROJ + nq * NP + Q_OFF + nxt.head * 128 + ks * 32 + fq * 8); }
        NA_PUT(15, R3, nxt, 3);                          NA_BAR(); if constexpr (!(skip & 1)) na_vstep<5>(st, ring, shift, kc0, fr, fq);
        NA_PUT(16, R4, nxt, 4);                          NA_BAR(); if constexpr (!(skip & 1)) na_vstep<6>(st, ring, shift, kc0, fr, fq);
        NA_PUT(17, R5, nxt, 5);                          NA_BAR(); if constexpr (!(skip & 1)) na_vstep<7>(st, ring, shift, kc0, fr, fq);
#undef NA_PUT
        if constexpr (!(skip & 4))
#pragma unroll
        for (int dt = 0; dt < 8; ++dt) {
            const f32x4 o = st.o[dt]; const u32x2 z = st.z[dt]; const float inv = st.inv;
            u32x2 y; y.x = cvt_pk_bf16(o[0] * inv * siluf_(bflo(z.x)), o[1] * inv * siluf_(bfhi(z.x))); y.y = cvt_pk_bf16(o[2] * inv * siluf_(bflo(z.y)), o[3] * inv * siluf_(bfhi(z.y)));
            *(u32x2*)(Y + qtok * DM + head * 128 + dt * 16 + 4 * fq) = y;
        }
        cur = nxt;
    }
    __syncthreads();
}

struct SgPre { u32x4 vs[4]; u32x2 u[8], z[8]; float bb[8]; float lg, lb; };
__device__ __forceinline__ void sg_fetch(SgPre& P, u32x4 (&WR)[4], const char* PROJ, const char* VT, const char* Wsb, const float* lng, const float* lnb, const float* bs,
                                         int chunk, int g, int wid, int fr, int fq, int tid) {
    const int ch = g * 128 + 16 * wid + fr, c4 = g * 128 + 16 * wid + 4 * fq;
    const unsigned woff = (unsigned)g * 32768u + (unsigned)tid * 16u;
#pragma unroll
    for (int i = 0; i < 4; ++i) WR[i] = *(const u32x4*)(Wsb + (size_t)(woff + 8192u * i));
#pragma unroll
    for (int ks = 0; ks < 4; ++ks) { const int t0 = 32 * ks + 8 * fq; const unsigned vo = ((unsigned)((chunk * 2 + (t0 >> 6)) * 2048 + 1024 + ch) * 64u + (unsigned)(t0 & 63)) * 2u; P.vs[ks] = *(const u32x4*)(VT + (size_t)vo); }
    const unsigned uo = ((unsigned)(chunk * 128 + fr) * (unsigned)NP + (unsigned)(U_OFF + c4)) * 2u;
#pragma unroll
    for (int st = 0; st < 8; ++st) { const unsigned o = uo + (unsigned)st * (16u * NP * 2u);
        P.u[st] = *(const u32x2*)(PROJ + (size_t)o); P.z[st] = *(const u32x2*)(PROJ + (size_t)o + (ZB_OFF - U_OFF) * 2); P.bb[st] = bs[g * 128 + st * 16 + fr]; }
    P.lg = lng[ch]; P.lb = lnb[ch];
}
__device__ __forceinline__ void sg_group(const SgPre& P, const LAS unsigned char* wb, const LAS float* mu, const LAS float* rsd, char* Y, int tok0, int g, int wid, int fr, int fq) {
    const float lg = P.lg, lb = P.lb;
    bf16x8 af[4];
#pragma unroll
    for (int ks = 0; ks < 4; ++ks) {
        const int t0 = 32 * ks + 8 * fq; const u32x4 v = P.vs[ks];
        const f32x4 m0 = *(const LAS f32x4*)(mu + t0), m1 = *(const LAS f32x4*)(mu + t0 + 4), r0 = *(const LAS f32x4*)(rsd + t0), r1 = *(const LAS f32x4*)(rsd + t0 + 4);
        u32x4 w;
        w.x = cvt_pk_bf16((bflo(v.x) - m0[0]) * r0[0] * lg + lb, (bfhi(v.x) - m0[1]) * r0[1] * lg + lb);
        w.y = cvt_pk_bf16((bflo(v.y) - m0[2]) * r0[2] * lg + lb, (bfhi(v.y) - m0[3]) * r0[3] * lg + lb);
        w.z = cvt_pk_bf16((bflo(v.z) - m1[0]) * r1[0] * lg + lb, (bfhi(v.z) - m1[1]) * r1[1] * lg + lb);
        w.w = cvt_pk_bf16((bflo(v.w) - m1[2]) * r1[2] * lg + lb, (bfhi(v.w) - m1[3]) * r1[3] * lg + lb);
        af[ks] = __builtin_bit_cast(bf16x8, w);
    }
    const unsigned yo = ((unsigned)(tok0 + fr) * (unsigned)DM + (unsigned)(g * 128 + 16 * wid + 4 * fq)) * 2u;
#pragma unroll
    for (int st = 0; st < 8; ++st) {
        const LAS unsigned char* wp = wb + (st * 16 + fr) * 288 + fq * 16;
        f32x4 a = {0.f, 0.f, 0.f, 0.f};
#pragma unroll
        for (int ks = 0; ks < 4; ++ks) { const bf16x8 wf = *(const LAS bf16x8*)(wp + ks * 64); a = __builtin_amdgcn_mfma_f32_16x16x32_bf16(af[ks], wf, a, 0, 0, 0); }
        const float bb = P.bb[st]; const u32x2 uu = P.u[st], z = P.z[st];
        u32x2 y;
        y.x = cvt_pk_bf16(bflo(uu.x) * (a[0] + bb) * siluf_(bflo(z.x)), bfhi(uu.x) * (a[1] + bb) * siluf_(bfhi(z.x)));
        y.y = cvt_pk_bf16(bflo(uu.y) * (a[2] + bb) * siluf_(bflo(z.y)), bfhi(uu.y) * (a[3] + bb) * siluf_(bfhi(z.y)));
        *(u32x2*)(Y + (size_t)(yo + (unsigned)st * (16u * DM * 2u))) = y;
    }
}
__device__ __forceinline__ void sg_phase(const Params& p, int layer, LAS unsigned char* lds, const int tid) {
    LAS float* red = (LAS float*)(lds + 73728);
    LAS float* mu = (LAS float*)(lds + 73728 + 8192);
    LAS float* rsd = mu + 128;
    const char* PROJ = (const char*)(p.ws + WS_PROJ); const char* VT = (const char*)(p.ws + WS_VT); char* Y = (char*)(p.ws + WS_H) + 2048;
    const char* Wsb = (const char*)(p.ws + WS_W + layer * SZ_LAYER_W + OFF_SGW);
    const float* lng = p.ln_g + layer * 1024; const float* lnb = p.ln_b + layer * 1024; const float* bs = p.sg_b + layer * 1024;
    const int wid = __builtin_amdgcn_readfirstlane(tid >> 6), lane = tid & 63, fr = lane & 15, fq = lane >> 4;
    for (int chunk = blockIdx.x; chunk < 256; chunk += gridDim.x) {
        const int tok0 = chunk * 128;
        __syncthreads();
        SgPre P0, P1; u32x4 WR[4];
        sg_fetch(P0, WR, PROJ, VT, Wsb, lng, lnb, bs, chunk, 0, wid, fr, fq, tid);
        { const int tg = tid & 15; float s1[8], s2[8];
#pragma unroll
          for (int e = 0; e < 8; ++e) { s1[e] = 0.f; s2[e] = 0.f; }
          const unsigned vb = ((unsigned)((chunk * 2 + (tg >> 3)) * 2048 + 1024 + (tid >> 4)) * 64u + (unsigned)((tg & 7) * 8)) * 2u;
#pragma unroll 16
          for (int i = 0; i < 32; ++i) { const u32x4 v = *(const u32x4*)(VT + (size_t)(vb + (unsigned)i * 4096u));
              const unsigned w[4] = {v.x, v.y, v.z, v.w};
#pragma unroll
              for (int e = 0; e < 4; ++e) { const float f0 = bflo(w[e]), f1 = bfhi(w[e]); s1[2 * e] += f0; s1[2 * e + 1] += f1; s2[2 * e] += f0 * f0; s2[2 * e + 1] += f1 * f1; } }
#pragma unroll
          for (int e = 0; e < 8; ++e) { s1[e] += __shfl_xor(s1[e], 16); s1[e] += __shfl_xor(s1[e], 32); s2[e] += __shfl_xor(s2[e], 16); s2[e] += __shfl_xor(s2[e], 32); }
          if (lane < 16) {
#pragma unroll
              for (int e = 0; e < 8; ++e) { red[(wid * 128 + tg * 8 + e) * 2] = s1[e]; red[(wid * 128 + tg * 8 + e) * 2 + 1] = s2[e]; } } }
        NA_BAR();
        if (tid < 128) { float a = 0.f, q = 0.f;
#pragma unroll
            for (int pp = 0; pp < 8; ++pp) { a += red[(pp * 128 + tid) * 2]; q += red[(pp * 128 + tid) * 2 + 1]; }
            const float mean = a * (1.0f / 1024.f); const float var = fmaxf(q * (1.0f / 1024.f) - mean * mean, 0.f);
            mu[tid] = mean; rsd[tid] = __builtin_amdgcn_rsqf(var + 1e-5f); }
        NA_BAR();
#define SG_GROUP(G, B, PC, PN, MORE) do { \
            { LAS unsigned char* wd = lds + (B) * 36864 + (tid >> 4) * 288 + (tid & 15) * 16; \
              _Pragma("unroll") for (int i = 0; i < 4; ++i) *(LAS u32x4*)(wd + i * 32 * 288) = WR[i]; } \
            if (MORE) sg_fetch(PN, WR, PROJ, VT, Wsb, lng, lnb, bs, chunk, (G) + 1, wid, fr, fq, tid); \
            NA_BAR(); \
            sg_group(PC, lds + (B) * 36864, mu, rsd, Y, tok0, (G), wid, fr, fq); } while (0)
#pragma unroll 1
        for (int g2 = 0; g2 < 4; ++g2) { SG_GROUP(2 * g2, 0, P0, P1, true); SG_GROUP(2 * g2 + 1, 1, P1, P0, g2 < 3); }
#undef SG_GROUP
    }
}

struct CvtTile { const float* src; bf16_t* dst; int N, ldw; };
__device__ __forceinline__ CvtTile cvt_decode(const Params& p, int t) {
    constexpr int T_IN = 32 * 176, T_P = 16 * 32, T_LAYER = T_IN + 2 * T_P + 32 * 32;
    const int layer = t / T_LAYER; int r = t % T_LAYER;
    unsigned char* wl = p.ws + WS_W + layer * SZ_LAYER_W; CvtTile c;
    if (r < T_IN) { const int kt = r & 31, nt = r >> 5; c.N = NIN; c.ldw = DM; c.src = p.w_in + (size_t)layer * DM * NIN + (size_t)(kt * 64) * NIN + nt * 64; c.dst = (bf16_t*)(wl + OFF_WIN) + (size_t)win_row(nt * 64) * DM + kt * 64; }
    else if ((r -= T_IN) < T_P) { const int kt = r & 15, nt = r >> 4; c.N = DM; c.ldw = DM; c.src = p.w_pa + (size_t)layer * 1024 * DM + (size_t)(kt * 64) * DM + nt * 64; c.dst = (bf16_t*)(wl + OFF_WPA) + (size_t)(nt * 64) * DM + kt * 64; }
    else if ((r -= T_P) < T_P) { const int kt = r & 15, nt = r >> 4; c.N = DM; c.ldw = DM; c.src = p.w_pb + (size_t)layer * 1024 * DM + (size_t)(kt * 64) * DM + nt * 64; c.dst = (bf16_t*)(wl + OFF_WPA) + (size_t)(nt * 64) * DM + 1024 + kt * 64; }
    else { r -= T_P; const int kt = r & 31, nt = r >> 5; c.N = DM; c.ldw = DM; c.src = p.w_out + (size_t)layer * DM * DM + (size_t)(kt * 64) * DM + nt * 64; c.dst = (bf16_t*)(wl + OFF_WOUT) + (size_t)(nt * 64) * DM + kt * 64; }
    return c;
}
__device__ __forceinline__ void prologue(const Params& p, LAS unsigned char* lds, const int tid) {
    constexpr int T_TOTAL = DEPTH * (32 * 176 + 2 * 16 * 32 + 32 * 32);
    { const int kk = tid >> 4, n4 = (tid & 15) * 4, wn = tid >> 3, wks = (tid & 7) * 8;
      int t = blockIdx.x; f32x4 v0, v1; CvtTile cur;
      if (t < T_TOTAL) { cur = cvt_decode(p, t); v0 = *(const f32x4*)(cur.src + (size_t)kk * cur.N + n4); v1 = *(const f32x4*)(cur.src + (size_t)(kk + 32) * cur.N + n4); }
      for (int it = 0; t < T_TOTAL; t += gridDim.x, ++it) {
          LAS bf16_t* tl = (LAS bf16_t*)lds + (it & 1) * (64 * 72);
#pragma unroll
          for (int e = 0; e < 4; ++e) { tl[(n4 + e) * 72 + kk] = (bf16_t)f2bf(v0[e]); tl[(n4 + e) * 72 + kk + 32] = (bf16_t)f2bf(v1[e]); }
          const CvtTile me = cur;
          if (t + (int)gridDim.x < T_TOTAL) { cur = cvt_decode(p, t + gridDim.x); v0 = *(const f32x4*)(cur.src + (size_t)kk * cur.N + n4); v1 = *(const f32x4*)(cur.src + (size_t)(kk + 32) * cur.N + n4); }
          NA_BAR();
          const u32x4 w = *(const LAS u32x4*)(tl + wn * 72 + wks);
          *(u32x4*)(me.dst + (size_t)wn * me.ldw + wks) = w;
      }
      __syncthreads(); }
    for (int i = blockIdx.x * 512 + tid; i < DEPTH * 8 * 128 * 128 / 4; i += gridDim.x * 512) {
        const int layer = i / (8 * 128 * 128 / 4), e = i % (8 * 128 * 128 / 4);
        const f32x4 v = *(const f32x4*)(p.sg_w + (size_t)layer * 8 * 128 * 128 + e * 4);
        u32x2 w; w.x = cvt_pk_bf16(v[0], v[1]); w.y = cvt_pk_bf16(v[2], v[3]);
        *(u32x2*)((bf16_t*)(p.ws + WS_W + layer * SZ_LAYER_W + OFF_SGW) + e * 4) = w;
    }
    rms_rows(p.x, p.pre_g, (bf16_t*)(p.ws + WS_H), tid);
}

#define XB_TMO      128
#define XB_XCNT(j)  (256  + 64 * (j))
#define XB_XSUB(j)  (1280 + 64 * (j))
#define XB_XGEN(j)  (2304 + 64 * (j))
#define XB_TOP      3328
#define XB_TOPGEN   3392
#define XCD_BAR_WORDS 3456
#define XB_SPIN_CAP (1u << 22)
__device__ __forceinline__ unsigned xb_ld(unsigned* p)              { return __hip_atomic_load(p, __ATOMIC_RELAXED, __HIP_MEMORY_SCOPE_AGENT); }
__device__ __forceinline__ unsigned xb_add(unsigned* p, unsigned v) { return __hip_atomic_fetch_add(p, v, __ATOMIC_RELAXED, __HIP_MEMORY_SCOPE_AGENT); }
__device__ __forceinline__ unsigned xb_xcc_id() { return (unsigned)__builtin_amdgcn_s_getreg((3 << 11) | 20) & 0xFu; }
#define XB_SPIN(cond, bar) do { unsigned _sp = 0; while (cond) { __builtin_amdgcn_s_sleep(1); \
    if ((++_sp & 255u) == 0u) { if (xb_ld(&(bar)[XB_TMO])) break; if (_sp > XB_SPIN_CAP) { atomicAdd(&(bar)[XB_TMO], 1u); break; } } } } while (0)
__device__ __forceinline__ void xcd_barrier_complete(unsigned* bar, unsigned x, unsigned& nloc, unsigned& nx) {
    const unsigned G = gridDim.x * gridDim.y * gridDim.z;
    unsigned sum, cnt, mine, sp = 0u;
    for (;;) {
        sum = 0u; cnt = 0u; mine = 0u;
#pragma unroll
        for (unsigned j = 0; j < 16; ++j) { const unsigned c = xb_ld(&bar[XB_XCNT(j)]); sum += c; cnt += (c > 0u) ? 1u : 0u; mine = (j == x) ? c : mine; }
        if (sum == G) break;
        __builtin_amdgcn_s_sleep(1);
        if ((++sp & 255u) == 0u) { if (xb_ld(&bar[XB_TMO])) break; if (sp > XB_SPIN_CAP) { atomicAdd(&bar[XB_TMO], 1u); break; } }
    }
    nloc = mine > 0u ? mine : 1u; nx = cnt > 0u ? cnt : 1u;
}
__device__ __forceinline__ void xcd_barrier(unsigned* bar, volatile LAS unsigned* st) {
    asm volatile("s_waitcnt vmcnt(0)" ::: "memory");
    __syncthreads();
    if (threadIdx.x == 0) {
        const unsigned x = xb_xcc_id();
        __builtin_amdgcn_s_waitcnt(0);
        unsigned nloc = st[0], nx = st[1];
        if (nloc == 0u) { xcd_barrier_complete(bar, x, nloc, nx); st[0] = nloc; st[1] = nx; }
        const unsigned old = xb_add(&bar[XB_XSUB(x)], 1u);
        const unsigned gen = old / nloc;
        if (old + 1u == (gen + 1u) * nloc) {
            __builtin_amdgcn_fence(__ATOMIC_RELEASE, "agent");
            asm volatile("s_waitcnt vmcnt(0)" ::: "memory");
            const unsigned og = xb_add(&bar[XB_TOP], 1u);
            const unsigned tg = og / nx;
            if (og + 1u == (tg + 1u) * nx) xb_add(&bar[XB_TOPGEN], 1u);
            else XB_SPIN(xb_ld(&bar[XB_TOPGEN]) == tg, bar);
            __builtin_amdgcn_fence(__ATOMIC_ACQUIRE, "agent");
            xb_add(&bar[XB_XGEN(x)], 1u);
            asm volatile("s_waitcnt vmcnt(0)" ::: "memory");
        } else {
            XB_SPIN(xb_ld(&bar[XB_XGEN(x)]) == gen, bar);
            __builtin_amdgcn_fence(__ATOMIC_ACQUIRE, "agent");
            asm volatile("s_waitcnt vmcnt(0)" ::: "memory");
        }
    }
    __syncthreads();
}

#ifndef PPL
#define PPL 5
#endif
#ifndef NA_PROBE_SKIP
#define NA_PROBE_SKIP 0
#endif
constexpr int N_PHASES = 1 + PPL * DEPTH;
#ifndef REP0
#define REP0 1
#endif
#ifndef REPN
#define REPN 1
#endif
#ifndef REPS
#define REPS 1
#endif
#ifndef REP2
#define REP2 1
#endif
#ifndef REP3
#define REP3 1
#endif
#ifndef REPP
#define REPP 1
#endif
__global__ void __launch_bounds__(512, 2) fwd(Params p_, int ph_lo, int ph_hi) {
    extern __shared__ __attribute__((aligned(16))) unsigned char shm[];
    LAS unsigned char* lds = (LAS unsigned char*)shm;
    volatile LAS unsigned* xst = (volatile LAS unsigned*)(lds + 131072);
    if (threadIdx.x == 0) { xst[0] = 0u; xst[1] = 0u; }
    if (blockIdx.x == 0 && ph_lo == 0) { unsigned* bar0 = (unsigned*)(p_.ws + WS_BAR); for (int i = threadIdx.x; i < XCD_BAR_WORDS; i += 512) bar0[i] = 0u; }
    __syncthreads();
    for (int ph = ph_lo; ph < ph_hi; ++ph) {
        if (ph != ph_lo) {
            if (ph == 1) { cg::this_grid().sync(); if (threadIdx.x == 0) (void)xb_add(&((unsigned*)(p_.ws + WS_BAR))[XB_XCNT(xb_xcc_id())], 1u); }
            else { const __attribute__((address_space(4))) Params* pb = (const __attribute__((address_space(4))) Params*)__builtin_amdgcn_kernarg_segment_ptr(); xcd_barrier((unsigned*)(pb->ws + WS_BAR), xst); }
        }
        int tid = threadIdx.x; asm volatile("" : "+v"(tid));
        const __attribute__((address_space(4))) Params* pp = (const __attribute__((address_space(4))) Params*)__builtin_amdgcn_kernarg_segment_ptr(); asm volatile("" : "+s"(pp));
        Params p;
        p.x = pp->x; p.pre_g = pp->pre_g; p.post_g = pp->post_g; p.w_in = pp->w_in; p.rpb = pp->rpb; p.ln_g = pp->ln_g; p.ln_b = pp->ln_b; p.sg_w = pp->sg_w; p.sg_b = pp->sg_b;
        p.w_pa = pp->w_pa; p.w_pb = pp->w_pb; p.w_out = pp->w_out; p.out = pp->out; p.ws = pp->ws;
        bf16_t* H = (bf16_t*)(p.ws + WS_H); bf16_t* VT = (bf16_t*)(p.ws + WS_VT); bf16_t* PROJ = (bf16_t*)(p.ws + WS_PROJ);
        float* T1 = (float*)(p.ws + WS_PROJ);
        float* OUT = T1;
        if (ph == 0) { for (int rep = 0; rep < REPP; ++rep) { prologue(p, lds, tid); __syncthreads(); } continue; }
        const int layer = (ph - 1) / PPL, kk = (ph - 1) % PPL, k = (PPL == 6) ? (kk == 0 ? 0 : kk == 1 ? 5 : kk - 1) : kk;
        const unsigned char* wl = p.ws + WS_W + layer * SZ_LAYER_W;
        #if PPL == 6
        if (k == 5) { na_phase<NA_PROBE_SKIP>(p, layer, lds, tid); } else
#endif
        if (k == 1) { na_phase<0>(p, layer, lds, tid); if (k == 1) { sg_phase(p, layer, lds, tid); __syncthreads(); } }
        else if (k == 4) {
            post_rows(layer == 0 ? p.x : p.out, PROJ, p.post_g + layer * DM, p.out, (layer + 1 < DEPTH) ? p.pre_g + (layer + 1) * DM : nullptr, H, tid);
        } else {
            const int njobs = (k == 0) ? 2 : 1, reps = (k == 0) ? REP0 : (k == 2) ? REP2 : REP3;
            for (int jj = 0; jj < njobs * reps; ++jj) { const int j = jj % njobs;
                pg8::Gemm g; pg8::Epi E; E.obf = nullptr; E.ldo = 0; E.sigcol = 0x7fffffff; E.gate = nullptr; E.ldg = 0; E.kt = nullptr;
                if (k == 0 && j == 0) { g.A = H; g.lda = DM; g.Bt = (const bf16_t*)(wl + OFF_WIN); g.ldb = DM; g.M = NTOK; g.N = NP; g.K = DM; E.mode = 0; E.obf = PROJ; E.ldo = NP; E.sigcol = GA_OFF; E.kt = (bf16_t*)(p.ws + WS_KT); }
                else if (k == 0) { g.A = (const bf16_t*)(wl + OFF_WIN) + (size_t)NP * DM; g.lda = DM; g.Bt = H; g.ldb = DM; g.M = 2048; g.N = NTOK; g.K = DM; E.mode = 4; E.obf = VT; E.ldo = 0; }
                else if (k == 2) { g.A = H; g.lda = DM; g.Bt = (const bf16_t*)(wl + OFF_WPA); g.ldb = DM; g.M = NTOK; g.N = DM; g.K = DM; E.mode = 2; E.gate = PROJ + GA_OFF; E.ldg = NP; E.obf = VT; E.ldo = DM; }
                else { g.A = VT; g.lda = DM; g.Bt = (const bf16_t*)(wl + OFF_WOUT); g.ldb = DM; g.M = NTOK; g.N = DM; g.K = DM; E.mode = 0; E.obf = PROJ; E.ldo = DM; }
                pg8::StaticOrder S; S.init(g.M, g.N, (int)gridDim.x, (int)blockIdx.x);
                pg8::gemm_phase(lds, g, S, E, tid);
                __syncthreads();
            }
        }
    }
}

extern "C" void kernel_launch(void* const* d_in, const int* in_sizes, int n_in, void* d_out, int out_size, void* d_ws, size_t ws_size, hipStream_t stream) {
    static int grid = 0;
    if (!grid) {
        if (n_in != 12 || in_sizes[0] != NTOK * DM || out_size != NTOK * DM || ws_size < WS_END) {
            fprintf(stderr, "kernel_launch: unexpected shapes (n_in %d, in0 %d, out %d, ws %zu, need %zu)\n", n_in, n_in > 0 ? in_sizes[0] : -1, out_size, ws_size, (size_t)WS_END); return; }
        int dev = 0, cus = 0, per_cu = 0;
        (void)hipGetDevice(&dev); (void)hipDeviceGetAttribute(&cus, hipDeviceAttributeMultiprocessorCount, dev);
        (void)hipFuncSetAttribute((const void*)fwd, hipFuncAttributeMaxDynamicSharedMemorySize, LDS_BYTES);
        (void)hipOccupancyMaxActiveBlocksPerMultiprocessor(&per_cu, (const void*)fwd, 512, LDS_BYTES);
        if (per_cu < 1) { fprintf(stderr, "kernel_launch: occupancy query says %d blocks per CU\n", per_cu); per_cu = 1; }
        grid = cus * per_cu;
    }
    Params p{};
    p.x = (const float*)d_in[0]; p.pre_g = (const float*)d_in[1]; p.post_g = (const float*)d_in[2]; p.w_in = (const float*)d_in[3]; p.rpb = (const float*)d_in[4];
    p.ln_g = (const float*)d_in[5]; p.ln_b = (const float*)d_in[6]; p.sg_w = (const float*)d_in[7]; p.sg_b = (const float*)d_in[8];
    p.w_pa = (const float*)d_in[9]; p.w_pb = (const float*)d_in[10]; p.w_out = (const float*)d_in[11]; p.out = (float*)d_out; p.ws = (unsigned char*)d_ws;
#ifdef MULTI_LAUNCH
    for (int ph = 0; ph < N_PHASES; ++ph) hipLaunchKernelGGL(fwd, dim3(grid), dim3(512), LDS_BYTES, stream, p, ph, ph + 1);
#else
    int lo = 0, hi = N_PHASES;
    void* args[] = {&p, &lo, &hi};
    hipError_t e = hipLaunchCooperativeKernel((const void*)fwd, dim3(grid), dim3(512), args, LDS_BYTES, stream);
    if (e != hipSuccess) fprintf(stderr, "cooperative launch failed: %s (grid %d)\n", hipGetErrorString(e), grid);
#endif
}
```

```cpp
#include <hip/hip_runtime.h>
#include <hip/hip_cooperative_groups.h>
#include <cstdio>
#include <cstdint>
namespace cg = cooperative_groups;

#define LAS __attribute__((address_space(3)))
typedef unsigned short bf16_t;
typedef short bf16x8 __attribute__((ext_vector_type(8)));
typedef float f32x4 __attribute__((ext_vector_type(4)));
typedef unsigned u32x4 __attribute__((ext_vector_type(4)));
typedef unsigned u32x2 __attribute__((ext_vector_type(2)));

constexpr int DM = 2048, NTOK = 32768, SEQ = 16384, NIN = 11264, DEPTH = 2;
constexpr int NP = 9216;
constexpr int Q_OFF = 0, K_OFF = 1024, ZA_OFF = 2048, U_OFF = 3072, ZB_OFF = 4096, GA_OFF = 5120, GB_OFF = 7168;
constexpr int RPB_N = 8 * 15 * 31;
constexpr size_t SZ_WIN = (size_t)NIN * DM * 2, SZ_WP = (size_t)DM * 1024 * 2, SZ_WOUT = (size_t)DM * DM * 2, SZ_SGW = (size_t)8 * 128 * 128 * 2;
constexpr size_t OFF_WIN = 0, OFF_WPA = OFF_WIN + SZ_WIN, OFF_WPB = OFF_WPA + SZ_WP, OFF_WOUT = OFF_WPB + SZ_WP, OFF_SGW = OFF_WOUT + SZ_WOUT, SZ_LAYER_W = OFF_SGW + SZ_SGW;
constexpr size_t WS_W = 0, WS_H = WS_W + DEPTH * SZ_LAYER_W, WS_VT = WS_H + (size_t)NTOK * DM * 2, WS_PROJ = WS_VT + (size_t)2048 * NTOK * 2,
                 WS_BAR = WS_PROJ + (size_t)NTOK * NP * 2, WS_KT = WS_BAR + 16384, WS_END = WS_KT + (size_t)NTOK * 1024 * 2;
constexpr int LDS_BYTES = 131072 + 64;

struct Params {
    const float* x; const float* pre_g; const float* post_g; const float* w_in; const float* rpb; const float* ln_g; const float* ln_b;
    const float* sg_w; const float* sg_b; const float* w_pa; const float* w_pb; const float* w_out; float* out; unsigned char* ws;
};

__device__ __forceinline__ unsigned f2bf(float f) { unsigned u = __builtin_bit_cast(unsigned, f); return (u + 0x7fffu + ((u >> 16) & 1u)) >> 16; }
__device__ __forceinline__ unsigned cvt_pk_bf16(float lo, float hi) { unsigned r; asm volatile("v_cvt_pk_bf16_f32 %0, %1, %2" : "=v"(r) : "v"(lo), "v"(hi)); return r; }
__device__ __forceinline__ float bflo(unsigned w) { return __builtin_bit_cast(float, w << 16); }
__device__ __forceinline__ float bfhi(unsigned w) { return __builtin_bit_cast(float, w & 0xffff0000u); }
__device__ __forceinline__ float sigmoidf_(float v) { return __builtin_amdgcn_rcpf(1.0f + __expf(-v)); }
__device__ __forceinline__ float siluf_(float v) { return v * sigmoidf_(v); }

namespace pg8 {
constexpr int BM = 256, BK = 64, HALF = 128, HTB = HALF * BK * 2, STAGE_BYTES = 8 * HTB, NXCD = 8, WGM = 8;
__host__ __device__ __forceinline__ int lds_byte(int r, int c) { const int st = (r >> 4) * 2 + (c >> 5), rr = r & 15, cc = c & 31, ob = rr * 64 + cc * 2; return st * 1024 + (ob ^ (((ob >> 9) & 1) << 5)); }
__host__ __device__ __forceinline__ void stage_rc(int b, int& R, int& C) { const int st = b / 1024, sb = b % 1024, swz = sb ^ (((sb >> 9) & 1) << 5); R = (st >> 1) * 16 + swz / 64; C = (st & 1) * 32 + (swz % 64) / 2; }
__host__ __device__ __forceinline__ int perm32(int rho) { const int n = rho >> 4, i = rho & 15; return 8 * (i >> 2) + 4 * n + (i & 3); }

struct Unit { int pm, pn; };
struct Gemm { const bf16_t* A; const bf16_t* Bt; int M, N, K, lda, ldb; };

struct StaticOrder {
    int nM, nN, nwg, G, c;
    __device__ void init(int M, int N, int G_, int c_) { nM = M / BM; nN = N / BM; nwg = nM * nN; G = G_; c = c_; }
    __device__ bool next(int i, Unit& u) const {
        const long L = (long)i * G + c; if (L >= nwg) return false;
        int wgid = (int)L; { const int q = nwg / NXCD, r = nwg % NXCD, xcd = wgid % NXCD, off = wgid / NXCD; wgid = (xcd < r ? xcd * (q + 1) : r * (q + 1) + (xcd - r) * q) + off; }
        const int nig = WGM * nN, gid = wgid / nig, fm = gid * WGM, gsz = (nM - fm) < WGM ? (nM - fm) : WGM;
        u.pm = fm + ((wgid % nig) % gsz); u.pn = (wgid % nig) / gsz; return true;
    }
};

struct Epi {
    int mode;
    bf16_t* obf; int ldo;
    int sigcol;
    bf16_t* kt;
    const bf16_t* gate; int ldg;
    __device__ __forceinline__ void operator()(const f32x4 (&acc)[2][2][4][2], const Unit& u, int wr, int wc, int fr, int fq) const {
        const int row0 = u.pm * BM + wr * 64 + fr, col0 = u.pn * BM + wc * 32 + 8 * fq;
        if (mode == 2) {
#pragma unroll
            for (int ai = 0; ai < 2; ++ai) {
                u32x4 GB[4][2];
#pragma unroll
                for (int m = 0; m < 4; ++m)
#pragma unroll
                    for (int bj = 0; bj < 2; ++bj) GB[m][bj] = *(const u32x4*)(gate + (size_t)(row0 + ai * HALF + m * 16) * ldg + col0 + bj * HALF + 2048);
                __builtin_amdgcn_sched_barrier(0);
#pragma unroll
                for (int m = 0; m < 4; ++m)
#pragma unroll
                    for (int bj = 0; bj < 2; ++bj) {
                        const u32x4 g = GB[m][bj]; f32x4 v0 = acc[ai][bj][m][0], v1 = acc[ai][bj][m][1];
                        v0[0] *= bflo(g.x); v0[1] *= bfhi(g.x); v0[2] *= bflo(g.y); v0[3] *= bfhi(g.y); v1[0] *= bflo(g.z); v1[1] *= bfhi(g.z); v1[2] *= bflo(g.w); v1[3] *= bfhi(g.w);
                        u32x4 w; w.x = cvt_pk_bf16(v0[0], v0[1]); w.y = cvt_pk_bf16(v0[2], v0[3]); w.z = cvt_pk_bf16(v1[0], v1[1]); w.w = cvt_pk_bf16(v1[2], v1[3]);
                        *(u32x4*)(obf + (size_t)(row0 + ai * HALF + m * 16) * ldo + col0 + bj * HALF) = w;
                    }
                __builtin_amdgcn_sched_barrier(0);
            }
            return;
        }
        if ((mode == 0) && (u.pn * BM >= sigcol)) {
            const int c0 = sigcol + (u.pn - sigcol / BM) * HALF + wc * 32 + 8 * fq;
#pragma unroll
            for (int ai = 0; ai < 2; ++ai)
#pragma unroll
                for (int m = 0; m < 4; ++m) {
                    const size_t row = (size_t)(row0 + ai * HALF + m * 16);
                    float rr[8], sb[8];
#pragma unroll
                    for (int e = 0; e < 8; ++e) { const float ga = acc[ai][0][m][e >> 2][e & 3], gb = acc[ai][1][m][e >> 2][e & 3];
                        const float eb = 1.0f + __expf(-gb); sb[e] = __builtin_amdgcn_rcpf(eb); rr[e] = eb * __builtin_amdgcn_rcpf(1.0f + __expf(-ga)); }
                    u32x4 w; w.x = cvt_pk_bf16(rr[0], rr[1]); w.y = cvt_pk_bf16(rr[2], rr[3]); w.z = cvt_pk_bf16(rr[4], rr[5]); w.w = cvt_pk_bf16(rr[6], rr[7]);
                    *(u32x4*)(obf + row * ldo + c0) = w;
                    w.x = cvt_pk_bf16(sb[0], sb[1]); w.y = cvt_pk_bf16(sb[2], sb[3]); w.z = cvt_pk_bf16(sb[4], sb[5]); w.w = cvt_pk_bf16(sb[6], sb[7]);
                    *(u32x4*)(obf + row * ldo + c0 + 2048) = w;
                }
            return;
        }
        const bool sg = false;
        const bool ktile = (mode == 0) && (kt != nullptr) && (u.pn >= 4) && (u.pn < 8);
#pragma unroll
        for (int ai = 0; ai < 2; ++ai)
#pragma unroll
            for (int m = 0; m < 4; ++m) {
                const size_t row = (size_t)(row0 + ai * HALF + m * 16);
#pragma unroll
                for (int bj = 0; bj < 2; ++bj) {
                    const int col = col0 + bj * HALF;
                    f32x4 v0 = acc[ai][bj][m][0], v1 = acc[ai][bj][m][1];
                    if (sg) {
#pragma unroll
                        for (int e = 0; e < 4; ++e) { v0[e] = sigmoidf_(v0[e]); v1[e] = sigmoidf_(v1[e]); }
                    }
                    u32x4 w; w.x = cvt_pk_bf16(v0[0], v0[1]); w.y = cvt_pk_bf16(v0[2], v0[3]); w.z = cvt_pk_bf16(v1[0], v1[1]); w.w = cvt_pk_bf16(v1[2], v1[3]);
                    if (ktile) __builtin_nontemporal_store(w, (u32x4*)(kt + (((row >> 6) * 8 + (size_t)((u.pn - 4) * 2 + bj)) * 64 + (row & 63)) * 128 + (wc * 32 + 8 * fq)));
                    else if (mode == 0) { if (kt != nullptr) __builtin_nontemporal_store(w, (u32x4*)(obf + row * ldo + col)); else *(u32x4*)(obf + row * ldo + col) = w; }
                    else *(u32x4*)(obf + ((size_t)(col >> 6) * 2048 + row) * 64 + (col & 63)) = w;
                }
            }
    }
    __device__ __forceinline__ void mid(f32x4 (&acc)[2][2][4][2], const Unit& u, int wr, int wc, int fr, int fq) const {
        int row0 = u.pm * BM + wr * 64 + fr, col0 = u.pn * BM + wc * 32 + 8 * fq;
        asm volatile("" : "+v"(row0), "+v"(col0));
        u32x4 RT[2][4][2];
#pragma unroll
        for (int ai = 0; ai < 2; ++ai)
#pragma unroll
            for (int m = 0; m < 4; ++m)
#pragma unroll
                for (int bj = 0; bj < 2; ++bj) RT[ai][m][bj] = *(const u32x4*)(gate + (size_t)(row0 + ai * HALF + m * 16) * ldg + col0 + bj * HALF);
        __builtin_amdgcn_sched_barrier(0);
#pragma unroll
        for (int ai = 0; ai < 2; ++ai)
#pragma unroll
            for (int m = 0; m < 4; ++m)
#pragma unroll
                for (int bj = 0; bj < 2; ++bj) {
                    const unsigned rw[4] = {RT[ai][m][bj].x, RT[ai][m][bj].y, RT[ai][m][bj].z, RT[ai][m][bj].w};
#pragma unroll
                    for (int i = 0; i < 4; ++i) { acc[ai][bj][m][i >> 1][(i & 1) * 2] *= bflo(rw[i]); acc[ai][bj][m][i >> 1][(i & 1) * 2 + 1] *= bfhi(rw[i]); }
                }
        __builtin_amdgcn_sched_barrier(0);
    }
};

__device__ __forceinline__ void gemm_phase(LAS unsigned char* lds, const Gemm g, const StaticOrder& S, const Epi& E, const int tid) {
    const int wid = __builtin_amdgcn_readfirstlane(tid >> 6), lane = tid & 63, wr = wid >> 2, wc = wid & 3, fr = lane & 15, fq = lane >> 4;
    const int K = g.K, nt = K / BK;
    unsigned voffA[2], voffB[2];
#pragma unroll
    for (int i = 0; i < 2; ++i) { int R, C; stage_rc(tid * 16 + i * 8192, R, C); const int Rb = (R & ~31) + perm32(R & 31);
        voffA[i] = (unsigned)(R * g.lda + C) * 2u; voffB[i] = (unsigned)(Rb * g.ldb + C) * 2u; }
    const size_t kstep = (size_t)(BK * 2);
    const size_t hstepA = (size_t)HALF * g.lda * 2, hstepB = (size_t)HALF * g.ldb * 2;
    const size_t tstepA = 2 * hstepA, tstepB = 2 * hstepB;
    const unsigned ldsw = (unsigned)wid * 1024u;
    const int aoff = lds_byte(wr * 64 + fr, fq * 8), boff = lds_byte(wc * 32 + fr, fq * 8);
#define PG8_SA(b, h) (((b) * 2 + (h)) * HTB)
#define PG8_SB(b, h) ((4 + (b) * 2 + (h)) * HTB)
#define PG8_STAGE(bufoff, gbase, voff) do { _Pragma("unroll") for (int _i = 0; _i < 2; ++_i) \
        __builtin_amdgcn_global_load_lds((const unsigned*)((const char*)(gbase) + (voff)[_i]), (LAS unsigned*)(lds + (bufoff) + ldsw + _i * 8192), 16, 0, 0); } while (0)
#define PG8_LDA(dst, b, h) do { _Pragma("unroll") for (int m = 0; m < 4; ++m) _Pragma("unroll") for (int k = 0; k < 2; ++k) dst[m][k] = *(const LAS bf16x8*)(lds + PG8_SA(b, h) + aoff + m * 2048 + k * 1024); } while (0)
#define PG8_LDB(dst, b, h) do { _Pragma("unroll") for (int n = 0; n < 2; ++n) _Pragma("unroll") for (int k = 0; k < 2; ++k) dst[n][k] = *(const LAS bf16x8*)(lds + PG8_SB(b, h) + boff + n * 2048 + k * 1024); } while (0)
#define PG8_MMA(ai, bj, At, Bt) do { __builtin_amdgcn_s_setprio(1); _Pragma("unroll") for (int m = 0; m < 4; ++m) _Pragma("unroll") for (int n = 0; n < 2; ++n) _Pragma("unroll") for (int k = 0; k < 2; ++k) \
        acc[ai][bj][m][n] = __builtin_amdgcn_mfma_f32_16x16x32_bf16(Bt[n][k], At[m][k], acc[ai][bj][m][n], 0, 0, 0); __builtin_amdgcn_s_setprio(0); } while (0)
#define PG8_WAIT_V(n) asm volatile("s_waitcnt vmcnt(" #n ")" ::: "memory")
#define PG8_WAIT_L(n) asm volatile("s_waitcnt lgkmcnt(" #n ")" ::: "memory")
#define PG8_BAR __builtin_amdgcn_s_barrier()
#define PG8_SCHED __builtin_amdgcn_sched_barrier(0)
    Unit cur, nxt; int ui = 0;
    if (!S.next(0, cur)) return;
    f32x4 acc[2][2][4][2];
#pragma unroll
    for (int a = 0; a < 2; ++a)
#pragma unroll
        for (int b = 0; b < 2; ++b)
#pragma unroll
            for (int m = 0; m < 4; ++m)
#pragma unroll
                for (int n = 0; n < 2; ++n) acc[a][b][m][n] = (f32x4){0.f, 0.f, 0.f, 0.f};
    bf16x8 At[4][2], B0[2][2], B1[2][2];
    const char* cA = (const char*)g.A + (size_t)cur.pm * tstepA; const char* cB = (const char*)g.Bt + (size_t)cur.pn * tstepB;
    PG8_STAGE(PG8_SB(0, 0), cB, voffB); PG8_STAGE(PG8_SB(0, 1), cB + hstepB, voffB); PG8_STAGE(PG8_SA(0, 0), cA, voffA); PG8_STAGE(PG8_SA(0, 1), cA + hstepA, voffA);
    if (wr == 1) PG8_BAR;
    PG8_WAIT_V(2); PG8_BAR;
    PG8_STAGE(PG8_SB(1, 0), cB + kstep, voffB); PG8_STAGE(PG8_SA(1, 0), cA + kstep, voffA); PG8_STAGE(PG8_SB(1, 1), cB + hstepB + kstep, voffB);
    PG8_WAIT_V(6); PG8_BAR;
    for (;;) {
        const bool has_next = S.next(ui + 1, nxt);
        const char* nA = has_next ? (const char*)g.A + (size_t)nxt.pm * tstepA : cA; const char* nB = has_next ? (const char*)g.Bt + (size_t)nxt.pn * tstepB : cB;
        for (int t = 0; t < nt; t += 2) {
            if (E.mode == 2 && t == (nt >> 1)) E.mid(acc, cur, wr, wc, fr, fq);
            const bool last = (t == nt - 2);
            const char* a1 = cA + (size_t)(t + 1) * kstep;
            const char* a2 = last ? nA : cA + (size_t)(t + 2) * kstep; const char* b2 = last ? nB : cB + (size_t)(t + 2) * kstep;
            const char* a3 = a2 + kstep; const char* b3 = b2 + kstep;
            PG8_LDB(B0, 0, 0); PG8_LDB(B1, 0, 1); PG8_SCHED; PG8_LDA(At, 0, 0); PG8_STAGE(PG8_SA(1, 1), a1 + hstepA, voffA);
            PG8_WAIT_V(8); PG8_WAIT_L(0); PG8_BAR; PG8_MMA(0, 0, At, B0); PG8_MMA(0, 1, At, B1); PG8_BAR; PG8_SCHED;
            PG8_LDA(At, 0, 1); PG8_STAGE(PG8_SB(0, 0), b2, voffB); PG8_STAGE(PG8_SB(0, 1), b2 + hstepB, voffB); PG8_STAGE(PG8_SA(0, 0), a2, voffA);
            PG8_WAIT_V(8); PG8_WAIT_L(0); PG8_BAR; PG8_MMA(1, 0, At, B0); PG8_MMA(1, 1, At, B1); PG8_BAR; PG8_SCHED;
            PG8_LDB(B0, 1, 0); PG8_LDB(B1, 1, 1); PG8_SCHED; PG8_LDA(At, 1, 0); PG8_STAGE(PG8_SA(0, 1), a2 + hstepA, voffA);
            PG8_WAIT_V(8); PG8_WAIT_L(0); PG8_BAR; PG8_MMA(0, 0, At, B0); PG8_MMA(0, 1, At, B1); PG8_BAR; PG8_SCHED;
            PG8_LDA(At, 1, 1); PG8_STAGE(PG8_SB(1, 0), b3, voffB); PG8_STAGE(PG8_SB(1, 1), b3 + hstepB, voffB); PG8_STAGE(PG8_SA(1, 0), a3, voffA);
            PG8_WAIT_V(8); PG8_WAIT_L(0); PG8_BAR; PG8_MMA(1, 0, At, B0); PG8_MMA(1, 1, At, B1); PG8_BAR; PG8_SCHED;
        }
        if (wr == 0) PG8_BAR;
        E(acc, cur, wr, wc, fr, fq);
#ifdef EPI2
        __builtin_amdgcn_sched_barrier(0); E(acc, cur, wr, wc, fr, fq);
#endif
        if (!has_next) break;
#pragma unroll
        for (int a = 0; a < 2; ++a)
#pragma unroll
            for (int b = 0; b < 2; ++b)
#pragma unroll
                for (int m = 0; m < 4; ++m)
#pragma unroll
                    for (int n = 0; n < 2; ++n) acc[a][b][m][n] = (f32x4){0.f, 0.f, 0.f, 0.f};
        cur = nxt; cA = nA; cB = nB; ++ui;
        if (wr == 1) PG8_BAR;
    }
    PG8_WAIT_V(0);
    PG8_BAR;
#undef PG8_SA
#undef PG8_SB
#undef PG8_STAGE
#undef PG8_LDA
#undef PG8_LDB
#undef PG8_MMA
#undef PG8_WAIT_V
#undef PG8_WAIT_L
#undef PG8_BAR
#undef PG8_SCHED
}
}

__device__ __forceinline__ void convert_tile(const float* W, bf16_t* Wt, int K, int N, int k0, int n0, int orow0, LAS bf16_t* tl, const int tid, int ldw, int kofs) {
    { const int kk = tid >> 4, n4 = (tid & 15) * 4;
#pragma unroll
      for (int h = 0; h < 2; ++h) { const int k = kk + 32 * h; const f32x4 v = *(const f32x4*)(W + (size_t)(k0 + k) * N + n0 + n4);
#pragma unroll
          for (int e = 0; e < 4; ++e) tl[(n4 + e) * 72 + k] = (bf16_t)f2bf(v[e]); } }
    __syncthreads();
    { const int n = tid >> 3, ks = (tid & 7) * 8; const u32x4 w = *(const LAS u32x4*)(tl + n * 72 + ks);
      *(u32x4*)(Wt + (size_t)(orow0 + n) * ldw + kofs + k0 + ks) = w; }
    __syncthreads();
}
__device__ __forceinline__ int win_row(int n0) {
    const int seg = n0 >> 10, r = n0 & 1023;
    switch (seg) { case 0: return r; case 1: return 1024 + r; case 2: return 9216 + r; case 3: return 2048 + r; case 4: return 3072 + r; case 5: return 10240 + r; case 6: return 4096 + r;
                   case 7: case 8: { const int c = n0 - 7168; return 5120 + (c >> 7) * 256 + (c & 127); }
                   default: { const int c = n0 - 9216; return 5120 + (c >> 7) * 256 + 128 + (c & 127); } }
}

__device__ __forceinline__ void rms_rows(const float* x, const float* g, bf16_t* H, const int tid) {
    const int wid = tid >> 6, lane = tid & 63, step = gridDim.x * 8;
    int row = blockIdx.x * 8 + wid;
    f32x4 v[8], vn[8], gg[8];
#pragma unroll
    for (int i = 0; i < 8; ++i) gg[i] = *(const f32x4*)(g + i * 256 + lane * 4);
    if (row < NTOK) {
#pragma unroll
        for (int i = 0; i < 8; ++i) v[i] = __builtin_nontemporal_load((const f32x4*)(x + (size_t)row * DM + i * 256 + lane * 4)); }
    for (; row < NTOK; row += step) {
        const int nrow = row + step;
        if (nrow < NTOK) {
#pragma unroll
            for (int i = 0; i < 8; ++i) vn[i] = __builtin_nontemporal_load((const f32x4*)(x + (size_t)nrow * DM + i * 256 + lane * 4)); }
        float ss = 0.f;
#pragma unroll
        for (int i = 0; i < 8; ++i) ss += v[i][0] * v[i][0] + v[i][1] * v[i][1] + v[i][2] * v[i][2] + v[i][3] * v[i][3];
#pragma unroll
        for (int o = 32; o > 0; o >>= 1) ss += __shfl_xor(ss, o);
        const float rstd = __builtin_amdgcn_rsqf(ss * (1.0f / DM) + 1e-6f);
#pragma unroll
        for (int i = 0; i < 8; ++i) {
            u32x2 w; w.x = cvt_pk_bf16(v[i][0] * rstd * gg[i][0], v[i][1] * rstd * gg[i][1]); w.y = cvt_pk_bf16(v[i][2] * rstd * gg[i][2], v[i][3] * rstd * gg[i][3]);
            *(u32x2*)(H + (size_t)row * DM + i * 256 + lane * 4) = w; }
#pragma unroll
        for (int i = 0; i < 8; ++i) v[i] = vn[i];
    }
}

__device__ __forceinline__ void post_rows(const float* xin, const bf16_t* OUT, const float* pg, float* out, const float* ng, bf16_t* H, const int tid) {
    const int wid = tid >> 6, lane = tid & 63, step = gridDim.x * 8;
    int row = blockIdx.x * 8 + wid;
    u32x2 ow[8], own[8]; f32x4 xw[8], xwn[8], pgv[8], ngv[8];
#pragma unroll
    for (int i = 0; i < 8; ++i) { pgv[i] = *(const f32x4*)(pg + i * 256 + lane * 4); ngv[i] = ng ? *(const f32x4*)(ng + i * 256 + lane * 4) : (f32x4){0.f, 0.f, 0.f, 0.f}; }
    if (row < NTOK) {
#pragma unroll
        for (int i = 0; i < 8; ++i) { ow[i] = __builtin_nontemporal_load((const u32x2*)(OUT + (size_t)row * DM + i * 256 + lane * 4)); xw[i] = __builtin_nontemporal_load((const f32x4*)(xin + (size_t)row * DM + i * 256 + lane * 4)); } }
    for (; row < NTOK; row += step) {
        const int nrow = row + step;
        if (nrow < NTOK) {
#pragma unroll
            for (int i = 0; i < 8; ++i) { own[i] = __builtin_nontemporal_load((const u32x2*)(OUT + (size_t)nrow * DM + i * 256 + lane * 4)); xwn[i] = __builtin_nontemporal_load((const f32x4*)(xin + (size_t)nrow * DM + i * 256 + lane * 4)); } }
        f32x4 o[8]; float ss = 0.f;
#pragma unroll
        for (int i = 0; i < 8; ++i) { const u32x2 w = ow[i];
            o[i][0] = bflo(w.x); o[i][1] = bfhi(w.x); o[i][2] = bflo(w.y); o[i][3] = bfhi(w.y); ss += o[i][0] * o[i][0] + o[i][1] * o[i][1] + o[i][2] * o[i][2] + o[i][3] * o[i][3]; }
#pragma unroll
        for (int s = 32; s > 0; s >>= 1) ss += __shfl_xor(ss, s);
        const float rstd = __builtin_amdgcn_rsqf(ss * (1.0f / DM) + 1e-6f);
        float s2 = 0.f;
#pragma unroll
        for (int i = 0; i < 8; ++i) { const f32x4 gg = pgv[i]; const f32x4 xv = xw[i];
            f32x4 r; r[0] = xv[0] + o[i][0] * rstd * gg[0]; r[1] = xv[1] + o[i][1] * rstd * gg[1]; r[2] = xv[2] + o[i][2] * rstd * gg[2]; r[3] = xv[3] + o[i][3] * rstd * gg[3];
            *(f32x4*)(out + (size_t)row * DM + i * 256 + lane * 4) = r; o[i] = r; s2 += r[0] * r[0] + r[1] * r[1] + r[2] * r[2] + r[3] * r[3]; }
        if (ng) {
#pragma unroll
            for (int s = 32; s > 0; s >>= 1) s2 += __shfl_xor(s2, s);
            const float rs2 = __builtin_amdgcn_rsqf(s2 * (1.0f / DM) + 1e-6f);
#pragma unroll
            for (int i = 0; i < 8; ++i) { const f32x4 gg = ngv[i];
                u32x2 w; w.x = cvt_pk_bf16(o[i][0] * rs2 * gg[0], o[i][1] * rs2 * gg[1]); w.y = cvt_pk_bf16(o[i][2] * rs2 * gg[2], o[i][3] * rs2 * gg[3]);
                *(u32x2*)(H + (size_t)row * DM + i * 256 + lane * 4) = w; }
        }
#pragma unroll
        for (int i = 0; i < 8; ++i) { ow[i] = own[i]; xw[i] = xwn[i]; }
    }
}

constexpr int NA_SLOT = 18432;
constexpr int NA_RPB_OFF = 3 * NA_SLOT;
#define NA_BAR() do { asm volatile("s_waitcnt lgkmcnt(0)" ::: "memory"); __builtin_amdgcn_s_barrier(); asm volatile("" ::: "memory"); } while (0)

struct NaUnit { int b, r0, head, rsA, delta; };
__device__ __forceinline__ NaUnit na_decode(int u) {
    NaUnit n; const int cc = u & 255, idx = cc >> 3; n.head = u >> 8; n.b = idx >> 4; n.r0 = 2 * ((cc & 7) * 16 + (idx & 15));
    n.rsA = min(max(n.r0 - 4, 0), 248); n.delta = min(max(n.r0 - 3, 0), 248) - n.rsA; return n; }

template <int I> __device__ __forceinline__ void na_issue(u32x4 (&R)[2], const bf16_t* KT, const bf16_t* VT, const NaUnit& n, const int tid) {
    if constexpr (I < 9) {
        const int row = min(n.rsA + I, 255);
        const bf16_t* base = KT + ((size_t)((n.b * 256 + row) * 8 + n.head)) * 8192 + tid * 8;
        R[0] = *(const u32x4*)base; R[1] = *(const u32x4*)(base + 4096);
    } else {
        const int row = min(n.rsA + (I - 9), 255);
        const bf16_t* base = VT + ((size_t)((n.b * 256 + row) * 2048 + n.head * 128)) * 64 + tid * 8;
        R[0] = *(const u32x4*)base; R[1] = *(const u32x4*)(base + 4096);
    }
}
template <int I> __device__ __forceinline__ void na_write(const u32x4 (&R)[2], LAS unsigned char* ring, const int tid) {
    LAS unsigned char* slot = ring + (I % 3) * NA_SLOT;
    if constexpr (I < 9) { LAS unsigned char* d = slot + (tid >> 4) * 288 + (tid & 15) * 16; *(LAS u32x4*)d = R[0]; *(LAS u32x4*)(d + 32 * 288) = R[1]; }
    else { LAS unsigned char* d = slot + (tid >> 3) * 144 + (tid & 7) * 16; *(LAS u32x4*)d = R[0]; *(LAS u32x4*)(d + 64 * 144) = R[1]; }
}

struct NaState { f32x4 s[8][2]; bf16x8 pf[8]; f32x4 o[8]; bf16x8 qf[4]; u32x2 z[8]; float inv; int idx[4]; bool sel[4]; unsigned m01, m23; };

template <int T> __device__ __forceinline__ void na_kstep(NaState& st, const LAS unsigned char* ring, int shift, int kc0, int fr, int fq) {
    const LAS unsigned char* base = ring + ((T + shift) % 3) * NA_SLOT + (kc0 + fr) * 288 + fq * 16;
    bf16x8 kf[2][4];
#pragma unroll
    for (int ct = 0; ct < 2; ++ct)
#pragma unroll
        for (int ks = 0; ks < 4; ++ks) kf[ct][ks] = *(const LAS bf16x8*)(base + ct * 16 * 288 + ks * 64);
    __builtin_amdgcn_sched_barrier(0);
    f32x4 a0 = {0.f, 0.f, 0.f, 0.f}, a1 = {0.f, 0.f, 0.f, 0.f};
#pragma unroll
    for (int ks = 0; ks < 4; ++ks) { a0 = __builtin_amdgcn_mfma_f32_16x16x32_bf16(kf[0][ks], st.qf[ks], a0, 0, 0, 0); a1 = __builtin_amdgcn_mfma_f32_16x16x32_bf16(kf[1][ks], st.qf[ks], a1, 0, 0, 0); }
    st.s[T][0] = a0; st.s[T][1] = a1;
}
template <int T> __device__ __forceinline__ void na_vstep(NaState& st, const LAS unsigned char* ring, int shift, int kc0, int fr, int fq) {
    const LAS unsigned char* vp = ring + ((9 + T + shift) % 3) * NA_SLOT + fr * 144 + (kc0 + 4 * fq) * 2;
    unsigned vph = (unsigned)(size_t)vp + 32u; asm volatile("" : "+v"(vph));
    const LAS unsigned char* vp2 = (const LAS unsigned char*)(size_t)vph;
    u32x2 lo[8], hi[8];
#pragma unroll
    for (int dt = 0; dt < 8; ++dt) { lo[dt] = *(const LAS u32x2*)(vp + dt * 16 * 144); hi[dt] = *(const LAS u32x2*)(vp2 + dt * 16 * 144); }
    __builtin_amdgcn_sched_barrier(0);
#pragma unroll
    for (int dt = 0; dt < 8; ++dt) {
        u32x4 w; w.x = lo[dt].x; w.y = lo[dt].y; w.z = hi[dt].x; w.w = hi[dt].y;
        st.o[dt] = __builtin_amdgcn_mfma_f32_16x16x32_bf16(__builtin_bit_cast(bf16x8, w), st.pf[T], st.o[dt], 0, 0, 0);
    }
}
__device__ __forceinline__ void na_softmax(NaState& st, const LAS float* rp, int head, int drow0) {
    const float scale2 = 0.08838834764831845f * 1.4426950408889634f;
    float mx = -1e30f;
#pragma unroll
    for (int ki = 0; ki < 8; ++ki) {
        const LAS float* row = rp + (head * 15 + drow0 + ki) * 32;
#pragma unroll
        for (int j = 0; j < 4; ++j) { const float sv = st.sel[j] ? st.s[ki][0][j] : st.s[ki][1][j]; const float v = __builtin_fmaf(sv, scale2, row[st.idx[j]]); st.s[ki][0][j] = v; mx = fmaxf(mx, v); }
    }
    mx = fmaxf(mx, __shfl_xor(mx, 16)); mx = fmaxf(mx, __shfl_xor(mx, 32));
    float sum = 0.f;
    const unsigned m01 = st.m01, m23 = st.m23;
#pragma unroll
    for (int ki = 0; ki < 8; ++ki) {
        float e[4];
#pragma unroll
        for (int j = 0; j < 4; ++j) { e[j] = __builtin_amdgcn_exp2f(st.s[ki][0][j] - mx); sum += e[j]; }
        const unsigned p01 = cvt_pk_bf16(e[0], e[1]), p23 = cvt_pk_bf16(e[2], e[3]);
        u32x4 w; w.x = p01 & m01; w.y = p23 & m23; w.z = p01 & ~m01; w.w = p23 & ~m23;
        st.pf[ki] = __builtin_bit_cast(bf16x8, w);
    }
    sum += __shfl_xor(sum, 16); sum += __shfl_xor(sum, 32);
    st.inv = 1.0f / sum;
#pragma unroll
    for (int dt = 0; dt < 8; ++dt) st.o[dt] = (f32x4){0.f, 0.f, 0.f, 0.f};
}

template <int skip> __device__ __forceinline__ void na_phase(const Params& p, int layer, LAS unsigned char* lds, const int tid) {
    LAS float* rp = (LAS float*)(lds + NA_RPB_OFF);
    for (int i = tid; i < 8 * 15 * 32; i += 512) { const int rw = i >> 5, cl = i & 31; rp[i] = (cl < 31) ? p.rpb[layer * RPB_N + rw * 31 + cl] * 1.4426950408889634f : -1e30f; }
    const bf16_t* PROJ = (const bf16_t*)(p.ws + WS_PROJ); const bf16_t* VT = (const bf16_t*)(p.ws + WS_VT); bf16_t* Y = (bf16_t*)(p.ws + WS_H); const bf16_t* KT = (const bf16_t*)(p.ws + WS_KT);
    const int wid = __builtin_amdgcn_readfirstlane(tid >> 6), lane = tid & 63, fr = lane & 15, fq = lane >> 4, ri = wid >> 2, qb = wid & 3;
    const int kc0 = (qb == 0) ? 0 : (qb == 1) ? 8 : (qb == 2) ? 24 : 32, qcol = 16 * qb + fr;
    const int G = (int)gridDim.x, c = (int)blockIdx.x;
    if (c >= 2048) { __syncthreads(); return; }
    LAS unsigned char* ring = lds;
    NaState st; u32x4 R0[2], R1[2], R2[2], R3[2], R4[2], R5[2];
    { const int cs = min(max(qcol - 8, 0), 48); unsigned m01 = 0u, m23 = 0u;
#pragma unroll
      for (int j = 0; j < 4; ++j) { const int k0 = kc0 + 4 * fq + j; const bool v0 = (k0 >= cs) && (k0 < cs + 16);
          st.sel[j] = v0; st.idx[j] = (v0 ? k0 : k0 + 16) - qcol + 15;
          if (v0) { if (j == 0) m01 |= 0xffffu; if (j == 1) m01 |= 0xffff0000u; if (j == 2) m23 |= 0xffffu; if (j == 3) m23 |= 0xffff0000u; } }
      st.m01 = m01; st.m23 = m23; }
    NaUnit cur = na_decode(c);
    na_issue<0>(R0, KT, VT, cur, tid); na_issue<1>(R1, KT, VT, cur, tid); na_issue<2>(R2, KT, VT, cur, tid);
    na_issue<3>(R3, KT, VT, cur, tid); na_issue<4>(R4, KT, VT, cur, tid); na_issue<5>(R5, KT, VT, cur, tid);
    { const size_t qtok = (size_t)(cur.b * SEQ + (cur.r0 + ri) * 64 + qcol);
#pragma unroll
      for (int ks = 0; ks < 4; ++ks) st.qf[ks] = *(const bf16x8*)(PROJ + qtok * NP + Q_OFF + cur.head * 128 + ks * 32 + fq * 8); }
    for (int u = c; u < 2048; u += G) {
        const bool has_next = (u + G) < 2048;
        const NaUnit nxt = has_next ? na_decode(u + G) : cur;
        const int my_r = cur.r0 + ri, shift = ri ? cur.delta : 0, head = cur.head;
        const size_t qtok = (size_t)(cur.b * SEQ + my_r * 64 + qcol);
#define NA_PUT(I, RR, NU, NI) do { if constexpr (!(skip & 8)) { na_write<I>(RR, ring, tid); na_issue<NI>(RR, KT, VT, NU, tid); } } while (0)
        NA_BAR();
        NA_PUT(0, R0, cur, 6); NA_PUT(1, R1, cur, 7);   NA_BAR(); if constexpr (!(skip & 1)) na_kstep<0>(st, ring, shift, kc0, fr, fq);
        NA_PUT(2, R2, cur, 8);                          NA_BAR(); if constexpr (!(skip & 1)) na_kstep<1>(st, ring, shift, kc0, fr, fq);
        NA_PUT(3, R3, cur, 9);                          NA_BAR(); if constexpr (!(skip & 1)) na_kstep<2>(st, ring, shift, kc0, fr, fq);
        NA_PUT(4, R4, cur, 10);                          NA_BAR(); if constexpr (!(skip & 1)) na_kstep<3>(st, ring, shift, kc0, fr, fq);
        NA_PUT(5, R5, cur, 11);                          NA_BAR(); if constexpr (!(skip & 1)) na_kstep<4>(st, ring, shift, kc0, fr, fq);
        NA_PUT(6, R0, cur, 12);                          NA_BAR(); if constexpr (!(skip & 1)) na_kstep<5>(st, ring, shift, kc0, fr, fq);
        NA_PUT(7, R1, cur, 13);                         NA_BAR(); if constexpr (!(skip & 1)) na_kstep<6>(st, ring, shift, kc0, fr, fq);
        NA_PUT(8, R2, cur, 14);                         NA_BAR(); if constexpr (!(skip & 1)) na_kstep<7>(st, ring, shift, kc0, fr, fq);
        if constexpr (!(skip & 2)) na_softmax(st, rp, head, (cur.rsA + shift) - my_r + 7);
        if constexpr (!(skip & 4)) {
#pragma unroll
        for (int dt = 0; dt < 8; ++dt) st.z[dt] = *(const u32x2*)(PROJ + qtok * NP + ZA_OFF + head * 128 + dt * 16 + 4 * fq); }
        NA_BAR();
        NA_PUT(9, R3, cur, 15); NA_PUT(10, R4, cur, 16); NA_BAR(); if constexpr (!(skip & 1)) na_vstep<0>(st, ring, shift, kc0, fr, fq);
        NA_PUT(11, R5, cur, 17);                         NA_BAR(); if constexpr (!(skip & 1)) na_vstep<1>(st, ring, shift, kc0, fr, fq);
        NA_PUT(12, R0, nxt, 0);                         NA_BAR(); if constexpr (!(skip & 1)) na_vstep<2>(st, ring, shift, kc0, fr, fq);
        NA_PUT(13, R1, nxt, 1);                         NA_BAR(); if constexpr (!(skip & 1)) na_vstep<3>(st, ring, shift, kc0, fr, fq);
        NA_PUT(14, R2, nxt, 2);                         NA_BAR(); if constexpr (!(skip & 1)) na_vstep<4>(st, ring, shift, kc0, fr, fq);
        { const size_t nq = (size_t)(nxt.b * SEQ + (nxt.r0 + ri) * 64 + qcol);
#pragma unroll
          for (int ks = 0; ks < 4; ++ks) st.qf[ks] = *(const bf16x8*)(PROJ + nq * NP + Q_OFF + nxt.head * 128 + ks * 32 + fq * 8); }
        NA_PUT(15, R3, nxt, 3);                          NA_BAR(); if constexpr (!(skip & 1)) na_vstep<5>(st, ring, shift, kc0, fr, fq);
        NA_PUT(16, R4, nxt, 4);                          NA_BAR(); if constexpr (!(skip & 1)) na_vstep<6>(st, ring, shift, kc0, fr, fq);
        NA_PUT(17, R5, nxt, 5);                          NA_BAR(); if constexpr (!(skip & 1)) na_vstep<7>(st, ring, shift, kc0, fr, fq);
#undef NA_PUT
        if constexpr (!(skip & 4))
#pragma unroll
        for (int dt = 0; dt < 8; ++dt) {
            const f32x4 o = st.o[dt]; const u32x2 z = st.z[dt]; const float inv = st.inv;
            u32x2 y; y.x = cvt_pk_bf16(o[0] * inv * siluf_(bflo(z.x)), o[1] * inv * siluf_(bfhi(z.x))); y.y = cvt_pk_bf16(o[2] * inv * siluf_(bflo(z.y)), o[3] * inv * siluf_(bfhi(z.y)));
            *(u32x2*)(Y + qtok * DM + head * 128 + dt * 16 + 4 * fq) = y;
        }
        cur = nxt;
    }
    __syncthreads();
}

struct SgPre { u32x4 vs[4]; u32x2 u[8], z[8]; float bb[8]; float lg, lb; };
__device__ __forceinline__ void sg_fetch(SgPre& P, u32x4 (&WR)[4], const char* PROJ, const char* VT, const char* Wsb, const float* lng, const float* lnb, const float* bs,
                                         int chunk, int g, int wid, int fr, int fq, int tid) {
    const int ch = g * 128 + 16 * wid + fr, c4 = g * 128 + 16 * wid + 4 * fq;
    const unsigned woff = (unsigned)g * 32768u + (unsigned)tid * 16u;
#pragma unroll
    for (int i = 0; i < 4; ++i) WR[i] = *(const u32x4*)(Wsb + (size_t)(woff + 8192u * i));
#pragma unroll
    for (int ks = 0; ks < 4; ++ks) { const int t0 = 32 * ks + 8 * fq; const unsigned vo = ((unsigned)((chunk * 2 + (t0 >> 6)) * 2048 + 1024 + ch) * 64u + (unsigned)(t0 & 63)) * 2u; P.vs[ks] = *(const u32x4*)(VT + (size_t)vo); }
    const unsigned uo = ((unsigned)(chunk * 128 + fr) * (unsigned)NP + (unsigned)(U_OFF + c4)) * 2u;
#pragma unroll
    for (int st = 0; st < 8; ++st) { const unsigned o = uo + (unsigned)st * (16u * NP * 2u);
        P.u[st] = *(const u32x2*)(PROJ + (size_t)o); P.z[st] = *(const u32x2*)(PROJ + (size_t)o + (ZB_OFF - U_OFF) * 2); P.bb[st] = bs[g * 128 + st * 16 + fr]; }
    P.lg = lng[ch]; P.lb = lnb[ch];
}
__device__ __forceinline__ void sg_group(const SgPre& P, const LAS unsigned char* wb, const LAS float* mu, const LAS float* rsd, char* Y, int tok0, int g, int wid, int fr, int fq) {
    const float lg = P.lg, lb = P.lb;
    bf16x8 af[4];
#pragma unroll
    for (int ks = 0; ks < 4; ++ks) {
        const int t0 = 32 * ks + 8 * fq; const u32x4 v = P.vs[ks];
        const f32x4 m0 = *(const LAS f32x4*)(mu + t0), m1 = *(const LAS f32x4*)(mu + t0 + 4), r0 = *(const LAS f32x4*)(rsd + t0), r1 = *(const LAS f32x4*)(rsd + t0 + 4);
        u32x4 w;
        w.x = cvt_pk_bf16((bflo(v.x) - m0[0]) * r0[0] * lg + lb, (bfhi(v.x) - m0[1]) * r0[1] * lg + lb);
        w.y = cvt_pk_bf16((bflo(v.y) - m0[2]) * r0[2] * lg + lb, (bfhi(v.y) - m0[3]) * r0[3] * lg + lb);
        w.z = cvt_pk_bf16((bflo(v.z) - m1[0]) * r1[0] * lg + lb, (bfhi(v.z) - m1[1]) * r1[1] * lg + lb);
        w.w = cvt_pk_bf16((bflo(v.w) - m1[2]) * r1[2] * lg + lb, (bfhi(v.w) - m1[3]) * r1[3] * lg + lb);
        af[ks] = __builtin_bit_cast(bf16x8, w);
    }
    const unsigned yo = ((unsigned)(tok0 + fr) * (unsigned)DM + (unsigned)(g * 128 + 16 * wid + 4 * fq)) * 2u;
#pragma unroll
    for (int st = 0; st < 8; ++st) {
        const LAS unsigned char* wp = wb + (st * 16 + fr) * 288 + fq * 16;
        f32x4 a = {0.f, 0.f, 0.f, 0.f};
#pragma unroll
        for (int ks = 0; ks < 4; ++ks) { const bf16x8 wf = *(const LAS bf16x8*)(wp + ks * 64); a = __builtin_amdgcn_mfma_f32_16x16x32_bf16(af[ks], wf, a, 0, 0, 0); }
        const float bb = P.bb[st]; const u32x2 uu = P.u[st], z = P.z[st];
        u32x2 y;
        y.x = cvt_pk_bf16(bflo(uu.x) * (a[0] + bb) * siluf_(bflo(z.x)), bfhi(uu.x) * (a[1] + bb) * siluf_(bfhi(z.x)));
        y.y = cvt_pk_bf16(bflo(uu.y) * (a[2] + bb) * siluf_(bflo(z.y)), bfhi(uu.y) * (a[3] + bb) * siluf_(bfhi(z.y)));
        *(u32x2*)(Y + (size_t)(yo + (unsigned)st * (16u * DM * 2u))) = y;
    }
}
__device__ __forceinline__ void sg_phase(const Params& p, int layer, LAS unsigned char* lds, const int tid) {
    LAS float* red = (LAS float*)(lds + 73728);
    LAS float* mu = (LAS float*)(lds + 73728 + 8192);
    LAS float* rsd = mu + 128;
    const char* PROJ = (const char*)(p.ws + WS_PROJ); const char* VT = (const char*)(p.ws + WS_VT); char* Y = (char*)(p.ws + WS_H) + 2048;
    const char* Wsb = (const char*)(p.ws + WS_W + layer * SZ_LAYER_W + OFF_SGW);
    const float* lng = p.ln_g + layer * 1024; const float* lnb = p.ln_b + layer * 1024; const float* bs = p.sg_b + layer * 1024;
    const int wid = __builtin_amdgcn_readfirstlane(tid >> 6), lane = tid & 63, fr = lane & 15, fq = lane >> 4;
    for (int chunk = blockIdx.x; chunk < 256; chunk += gridDim.x) {
        const int tok0 = chunk * 128;
        __syncthreads();
        SgPre P0, P1; u32x4 WR[4];
        sg_fetch(P0, WR, PROJ, VT, Wsb, lng, lnb, bs, chunk, 0, wid, fr, fq, tid);
        { const int tg = tid & 15; float s1[8], s2[8];
#pragma unroll
          for (int e = 0; e < 8; ++e) { s1[e] = 0.f; s2[e] = 0.f; }
          const unsigned vb = ((unsigned)((chunk * 2 + (tg >> 3)) * 2048 + 1024 + (tid >> 4)) * 64u + (unsigned)((tg & 7) * 8)) * 2u;
#pragma unroll 16
          for (int i = 0; i < 32; ++i) { const u32x4 v = *(const u32x4*)(VT + (size_t)(vb + (unsigned)i * 4096u));
              const unsigned w[4] = {v.x, v.y, v.z, v.w};
#pragma unroll
              for (int e = 0; e < 4; ++e) { const float f0 = bflo(w[e]), f1 = bfhi(w[e]); s1[2 * e] += f0; s1[2 * e + 1] += f1; s2[2 * e] += f0 * f0; s2[2 * e + 1] += f1 * f1; } }
#pragma unroll
          for (int e = 0; e < 8; ++e) { s1[e] += __shfl_xor(s1[e], 16); s1[e] += __shfl_xor(s1[e], 32); s2[e] += __shfl_xor(s2[e], 16); s2[e] += __shfl_xor(s2[e], 32); }
          if (lane < 16) {
#pragma unroll
              for (int e = 0; e < 8; ++e) { red[(wid * 128 + tg * 8 + e) * 2] = s1[e]; red[(wid * 128 + tg * 8 + e) * 2 + 1] = s2[e]; } } }
        NA_BAR();
        if (tid < 128) { float a = 0.f, q = 0.f;
#pragma unroll
            for (int pp = 0; pp < 8; ++pp) { a += red[(pp * 128 + tid) * 2]; q += red[(pp * 128 + tid) * 2 + 1]; }
            const float mean = a * (1.0f / 1024.f); const float var = fmaxf(q * (1.0f / 1024.f) - mean * mean, 0.f);
            mu[tid] = mean; rsd[tid] = __builtin_amdgcn_rsqf(var + 1e-5f); }
        NA_BAR();
#define SG_GROUP(G, B, PC, PN, MORE) do { \
            { LAS unsigned char* wd = lds + (B) * 36864 + (tid >> 4) * 288 + (tid & 15) * 16; \
              _Pragma("unroll") for (int i = 0; i < 4; ++i) *(LAS u32x4*)(wd + i * 32 * 288) = WR[i]; } \
            if (MORE) sg_fetch(PN, WR, PROJ, VT, Wsb, lng, lnb, bs, chunk, (G) + 1, wid, fr, fq, tid); \
            NA_BAR(); \
            sg_group(PC, lds + (B) * 36864, mu, rsd, Y, tok0, (G), wid, fr, fq); } while (0)
#pragma unroll 1
        for (int g2 = 0; g2 < 4; ++g2) { SG_GROUP(2 * g2, 0, P0, P1, true); SG_GROUP(2 * g2 + 1, 1, P1, P0, g2 < 3); }
#undef SG_GROUP
    }
}

struct CvtTile { const float* src; bf16_t* dst; int N, ldw; };
__device__ __forceinline__ CvtTile cvt_decode(const Params& p, int t) {
    constexpr int T_IN = 32 * 176, T_P = 16 * 32, T_LAYER = T_IN + 2 * T_P + 32 * 32;
    const int layer = t / T_LAYER; int r = t % T_LAYER;
    unsigned char* wl = p.ws + WS_W + layer * SZ_LAYER_W; CvtTile c;
    if (r < T_IN) { const int kt = r & 31, nt = r >> 5; c.N = NIN; c.ldw = DM; c.src = p.w_in + (size_t)layer * DM * NIN + (size_t)(kt * 64) * NIN + nt * 64; c.dst = (bf16_t*)(wl + OFF_WIN) + (size_t)win_row(nt * 64) * DM + kt * 64; }
    else if ((r -= T_IN) < T_P) { const int kt = r & 15, nt = r >> 4; c.N = DM; c.ldw = DM; c.src = p.w_pa + (size_t)layer * 1024 * DM + (size_t)(kt * 64) * DM + nt * 64; c.dst = (bf16_t*)(wl + OFF_WPA) + (size_t)(nt * 64) * DM + kt * 64; }
    else if ((r -= T_P) < T_P) { const int kt = r & 15, nt = r >> 4; c.N = DM; c.ldw = DM; c.src = p.w_pb + (size_t)layer * 1024 * DM + (size_t)(kt * 64) * DM + nt * 64; c.dst = (bf16_t*)(wl + OFF_WPA) + (size_t)(nt * 64) * DM + 1024 + kt * 64; }
    else { r -= T_P; const int kt = r & 31, nt = r >> 5; c.N = DM; c.ldw = DM; c.src = p.w_out + (size_t)layer * DM * DM + (size_t)(kt * 64) * DM + nt * 64; c.dst = (bf16_t*)(wl + OFF_WOUT) + (size_t)(nt * 64) * DM + kt * 64; }
    return c;
}
__device__ __forceinline__ void prologue(const Params& p, LAS unsigned char* lds, const int tid) {
    constexpr int T_TOTAL = DEPTH * (32 * 176 + 2 * 16 * 32 + 32 * 32);
    { const int kk = tid >> 4, n4 = (tid & 15) * 4, wn = tid >> 3, wks = (tid & 7) * 8;
      int t = blockIdx.x; f32x4 v0, v1; CvtTile cur;
      if (t < T_TOTAL) { cur = cvt_decode(p, t); v0 = __builtin_nontemporal_load((const f32x4*)(cur.src + (size_t)kk * cur.N + n4)); v1 = __builtin_nontemporal_load((const f32x4*)(cur.src + (size_t)(kk + 32) * cur.N + n4)); }
      for (int it = 0; t < T_TOTAL; t += gridDim.x, ++it) {
          LAS bf16_t* tl = (LAS bf16_t*)lds + (it & 1) * (64 * 72);
#pragma unroll
          for (int e = 0; e < 4; ++e) { tl[(n4 + e) * 72 + kk] = (bf16_t)f2bf(v0[e]); tl[(n4 + e) * 72 + kk + 32] = (bf16_t)f2bf(v1[e]); }
          const CvtTile me = cur;
          if (t + (int)gridDim.x < T_TOTAL) { cur = cvt_decode(p, t + gridDim.x); v0 = __builtin_nontemporal_load((const f32x4*)(cur.src + (size_t)kk * cur.N + n4)); v1 = __builtin_nontemporal_load((const f32x4*)(cur.src + (size_t)(kk + 32) * cur.N + n4)); }
          NA_BAR();
          const u32x4 w = *(const LAS u32x4*)(tl + wn * 72 + wks);
          *(u32x4*)(me.dst + (size_t)wn * me.ldw + wks) = w;
      }
      __syncthreads(); }
    for (int i = blockIdx.x * 512 + tid; i < DEPTH * 8 * 128 * 128 / 4; i += gridDim.x * 512) {
        const int layer = i / (8 * 128 * 128 / 4), e = i % (8 * 128 * 128 / 4);
        const f32x4 v = *(const f32x4*)(p.sg_w + (size_t)layer * 8 * 128 * 128 + e * 4);
        u32x2 w; w.x = cvt_pk_bf16(v[0], v[1]); w.y = cvt_pk_bf16(v[2], v[3]);
        *(u32x2*)((bf16_t*)(p.ws + WS_W + layer * SZ_LAYER_W + OFF_SGW) + e * 4) = w;
    }
    rms_rows(p.x, p.pre_g, (bf16_t*)(p.ws + WS_H), tid);
}

#define XB_TMO      128
#define XB_XCNT(j)  (256  + 64 * (j))
#define XB_XSUB(j)  (1280 + 64 * (j))
#define XB_XGEN(j)  (2304 + 64 * (j))
#define XB_TOP      3328
#define XB_TOPGEN   3392
#define XCD_BAR_WORDS 3456
#define XB_SPIN_CAP (1u << 22)
__device__ __forceinline__ unsigned xb_ld(unsigned* p)              { return __hip_atomic_load(p, __ATOMIC_RELAXED, __HIP_MEMORY_SCOPE_AGENT); }
__device__ __forceinline__ unsigned xb_add(unsigned* p, unsigned v) { return __hip_atomic_fetch_add(p, v, __ATOMIC_RELAXED, __HIP_MEMORY_SCOPE_AGENT); }
__device__ __forceinline__ unsigned xb_xcc_id() { return (unsigned)__builtin_amdgcn_s_getreg((3 << 11) | 20) & 0xFu; }
#define XB_SPIN(cond, bar) do { unsigned _sp = 0; while (cond) { __builtin_amdgcn_s_sleep(1); \
    if ((++_sp & 255u) == 0u) { if (xb_ld(&(bar)[XB_TMO])) break; if (_sp > XB_SPIN_CAP) { atomicAdd(&(bar)[XB_TMO], 1u); break; } } } } while (0)
__device__ __forceinline__ void xcd_barrier_complete(unsigned* bar, unsigned x, unsigned& nloc, unsigned& nx) {
    const unsigned G = gridDim.x * gridDim.y * gridDim.z;
    unsigned sum, cnt, mine, sp = 0u;
    for (;;) {
        sum = 0u; cnt = 0u; mine = 0u;
#pragma unroll
        for (unsigned j = 0; j < 16; ++j) { const unsigned c = xb_ld(&bar[XB_XCNT(j)]); sum += c; cnt += (c > 0u) ? 1u : 0u; mine = (j == x) ? c : mine; }
        if (sum == G) break;
        __builtin_amdgcn_s_sleep(1);
        if ((++sp & 255u) == 0u) { if (xb_ld(&bar[XB_TMO])) break; if (sp > XB_SPIN_CAP) { atomicAdd(&bar[XB_TMO], 1u); break; } }
    }
    nloc = mine > 0u ? mine : 1u; nx = cnt > 0u ? cnt : 1u;
}
__device__ __forceinline__ void xcd_barrier(unsigned* bar, volatile LAS unsigned* st) {
    asm volatile("s_waitcnt vmcnt(0)" ::: "memory");
    __syncthreads();
    if (threadIdx.x == 0) {
        const unsigned x = xb_xcc_id();
        __builtin_amdgcn_s_waitcnt(0);
        unsigned nloc = st[0], nx = st[1];
        if (nloc == 0u) { xcd_barrier_complete(bar, x, nloc, nx); st[0] = nloc; st[1] = nx; }
        const unsigned old = xb_add(&bar[XB_XSUB(x)], 1u);
        const unsigned gen = old / nloc;
        if (old + 1u == (gen + 1u) * nloc) {
            __builtin_amdgcn_fence(__ATOMIC_RELEASE, "agent");
            asm volatile("s_waitcnt vmcnt(0)" ::: "memory");
            const unsigned og = xb_add(&bar[XB_TOP], 1u);
            const unsigned tg = og / nx;
            if (og + 1u == (tg + 1u) * nx) xb_add(&bar[XB_TOPGEN], 1u);
            else XB_SPIN(xb_ld(&bar[XB_TOPGEN]) == tg, bar);
            __builtin_amdgcn_fence(__ATOMIC_ACQUIRE, "agent");
            xb_add(&bar[XB_XGEN(x)], 1u);
            asm volatile("s_waitcnt vmcnt(0)" ::: "memory");
        } else {
            XB_SPIN(xb_ld(&bar[XB_XGEN(x)]) == gen, bar);
            __builtin_amdgcn_fence(__ATOMIC_ACQUIRE, "agent");
            asm volatile("s_waitcnt vmcnt(0)" ::: "memory");
        }
    }
    __syncthreads();
}

#ifndef PPL
#define PPL 5
#endif
#ifndef NA_PROBE_SKIP
#define NA_PROBE_SKIP 0
#endif
constexpr int N_PHASES = 1 + PPL * DEPTH;
#ifndef REP0
#define REP0 1
#endif
#ifndef REPN
#define REPN 1
#endif
#ifndef REPS
#define REPS 1
#endif
#ifndef REP2
#define REP2 1
#endif
#ifndef REP3
#define REP3 1
#endif
#ifndef REPP
#define REPP 1
#endif
__global__ void __launch_bounds__(512, 2) fwd(Params p_, int ph_lo, int ph_hi) {
    extern __shared__ __attribute__((aligned(16))) unsigned char shm[];
    LAS unsigned char* lds = (LAS unsigned char*)shm;
    volatile LAS unsigned* xst = (volatile LAS unsigned*)(lds + 131072);
    if (threadIdx.x == 0) { xst[0] = 0u; xst[1] = 0u; }
    if (blockIdx.x == 0 && ph_lo == 0) { unsigned* bar0 = (unsigned*)(p_.ws + WS_BAR); for (int i = threadIdx.x; i < XCD_BAR_WORDS; i += 512) bar0[i] = 0u; }
    __syncthreads();
    for (int ph = ph_lo; ph < ph_hi; ++ph) {
        if (ph != ph_lo) {
            if (ph == 1) { cg::this_grid().sync(); if (threadIdx.x == 0) (void)xb_add(&((unsigned*)(p_.ws + WS_BAR))[XB_XCNT(xb_xcc_id())], 1u); }
            else { const __attribute__((address_space(4))) Params* pb = (const __attribute__((address_space(4))) Params*)__builtin_amdgcn_kernarg_segment_ptr(); xcd_barrier((unsigned*)(pb->ws + WS_BAR), xst); }
        }
        int tid = threadIdx.x; asm volatile("" : "+v"(tid));
        const __attribute__((address_space(4))) Params* pp = (const __attribute__((address_space(4))) Params*)__builtin_amdgcn_kernarg_segment_ptr(); asm volatile("" : "+s"(pp));
        Params p;
        p.x = pp->x; p.pre_g = pp->pre_g; p.post_g = pp->post_g; p.w_in = pp->w_in; p.rpb = pp->rpb; p.ln_g = pp->ln_g; p.ln_b = pp->ln_b; p.sg_w = pp->sg_w; p.sg_b = pp->sg_b;
        p.w_pa = pp->w_pa; p.w_pb = pp->w_pb; p.w_out = pp->w_out; p.out = pp->out; p.ws = pp->ws;
        bf16_t* H = (bf16_t*)(p.ws + WS_H); bf16_t* VT = (bf16_t*)(p.ws + WS_VT); bf16_t* PROJ = (bf16_t*)(p.ws + WS_PROJ);
        float* T1 = (float*)(p.ws + WS_PROJ);
        float* OUT = T1;
        if (ph == 0) { for (int rep = 0; rep < REPP; ++rep) { prologue(p, lds, tid); __syncthreads(); } continue; }
        const int layer = (ph - 1) / PPL, kk = (ph - 1) % PPL, k = (PPL == 6) ? (kk == 0 ? 0 : kk == 1 ? 5 : kk - 1) : kk;
        const unsigned char* wl = p.ws + WS_W + layer * SZ_LAYER_W;
        #if PPL == 6
        if (k == 5) { na_phase<NA_PROBE_SKIP>(p, layer, lds, tid); } else
#endif
        if (k == 1) { na_phase<0>(p, layer, lds, tid); if (k == 1) { sg_phase(p, layer, lds, tid); __syncthreads(); } }
        else if (k == 4) {
            post_rows(layer == 0 ? p.x : p.out, PROJ, p.post_g + layer * DM, p.out, (layer + 1 < DEPTH) ? p.pre_g + (layer + 1) * DM : nullptr, H, tid);
        } else {
            const int njobs = (k == 0) ? 2 : 1, reps = (k == 0) ? REP0 : (k == 2) ? REP2 : REP3;
            for (int jj = 0; jj < njobs * reps; ++jj) { const int j = jj % njobs;
                pg8::Gemm g; pg8::Epi E; E.obf = nullptr; E.ldo = 0; E.sigcol = 0x7fffffff; E.gate = nullptr; E.ldg = 0; E.kt = nullptr;
                if (k == 0 && j == 0) { g.A = H; g.lda = DM; g.Bt = (const bf16_t*)(wl + OFF_WIN); g.ldb = DM; g.M = NTOK; g.N = NP; g.K = DM; E.mode = 0; E.obf = PROJ; E.ldo = NP; E.sigcol = GA_OFF; E.kt = (bf16_t*)(p.ws + WS_KT); }
                else if (k == 0) { g.A = (const bf16_t*)(wl + OFF_WIN) + (size_t)NP * DM; g.lda = DM; g.Bt = H; g.ldb = DM; g.M = 2048; g.N = NTOK; g.K = DM; E.mode = 4; E.obf = VT; E.ldo = 0; }
                else if (k == 2) { g.A = H; g.lda = DM; g.Bt = (const bf16_t*)(wl + OFF_WPA); g.ldb = DM; g.M = NTOK; g.N = DM; g.K = DM; E.mode = 2; E.gate = PROJ + GA_OFF; E.ldg = NP; E.obf = VT; E.ldo = DM; }
                else { g.A = VT; g.lda = DM; g.Bt = (const bf16_t*)(wl + OFF_WOUT); g.ldb = DM; g.M = NTOK; g.N = DM; g.K = DM; E.mode = 0; E.obf = PROJ; E.ldo = DM; }
                pg8::StaticOrder S; S.init(g.M, g.N, (int)gridDim.x, (int)blockIdx.x);
                pg8::gemm_phase(lds, g, S, E, tid);
                __syncthreads();
            }
        }
    }
}

extern "C" void kernel_launch(void* const* d_in, const int* in_sizes, int n_in, void* d_out, int out_size, void* d_ws, size_t ws_size, hipStream_t stream) {
    static int grid = 0;
    if (!grid) {
        if (n_in != 12 || in_sizes[0] != NTOK * DM || out_size != NTOK * DM || ws_size < WS_END) {
            fprintf(stderr, "kernel_launch: unexpected shapes (n_in %d, in0 %d, out %d, ws %zu, need %zu)\n", n_in, n_in > 0 ? in_sizes[0] : -1, out_size, ws_size, (size_t)WS_END); return; }
        int dev = 0, cus = 0, per_cu = 0;
        (void)hipGetDevice(&dev); (void)hipDeviceGetAttribute(&cus, hipDeviceAttributeMultiprocessorCount, dev);
        (void)hipFuncSetAttribute((const void*)fwd, hipFuncAttributeMaxDynamicSharedMemorySize, LDS_BYTES);
        (void)hipOccupancyMaxActiveBlocksPerMultiprocessor(&per_cu, (const void*)fwd, 512, LDS_BYTES);
        if (per_cu < 1) { fprintf(stderr, "kernel_launch: occupancy query says %d blocks per CU\n", per_cu); per_cu = 1; }
        grid = cus * per_cu;
    }
    Params p{};
    p.x = (const float*)d_in[0]; p.pre_g = (const float*)d_in[1]; p.post_g = (const float*)d_in[2]; p.w_in = (const float*)d_in[3]; p.rpb = (const float*)d_in[4];
    p.ln_g = (const float*)d_in[5]; p.ln_b = (const float*)d_in[6]; p.sg_w = (const float*)d_in[7]; p.sg_b = (const float*)d_in[8];
    p.w_pa = (const float*)d_in[9]; p.w_pb = (const float*)d_in[10]; p.w_out = (const float*)d_in[11]; p.out = (float*)d_out; p.ws = (unsigned char*)d_ws;
#ifdef MULTI_LAUNCH
    for (int ph = 0; ph < N_PHASES; ++ph) hipLaunchKernelGGL(fwd, dim3(grid), dim3(512), LDS_BYTES, stream, p, ph, ph + 1);
#else
    int lo = 0, hi = N_PHASES;
    void* args[] = {&p, &lo, &hi};
    hipError_t e = hipLaunchCooperativeKernel((const void*)fwd, dim3(grid), dim3(512), args, LDS_BYTES, stream);
    if (e != hipSuccess) fprintf(stderr, "cooperative launch failed: %s (grid %d)\n", hipGetErrorString(e), grid);
#endif
}
```

```cpp
#include <hip/hip_runtime.h>
#include <hip/hip_cooperative_groups.h>
#include <cstdio>
#include <cstdint>
namespace cg = cooperative_groups;

#define LAS __attribute__((address_space(3)))
typedef unsigned short bf16_t;
typedef short bf16x8 __attribute__((ext_vector_type(8)));
typedef float f32x4 __attribute__((ext_vector_type(4)));
typedef unsigned u32x4 __attribute__((ext_vector_type(4)));
typedef unsigned u32x2 __attribute__((ext_vector_type(2)));

constexpr int DM = 2048, NTOK = 32768, SEQ = 16384, NIN = 11264, DEPTH = 2;
constexpr int NP = 9216;
constexpr int Q_OFF = 0, K_OFF = 1024, ZA_OFF = 2048, U_OFF = 3072, ZB_OFF = 4096, GA_OFF = 5120, GB_OFF = 7168;
constexpr int RPB_N = 8 * 15 * 31;
constexpr size_t SZ_WIN = (size_t)NIN * DM * 2, SZ_WP = (size_t)DM * 1024 * 2, SZ_WOUT = (size_t)DM * DM * 2, SZ_SGW = (size_t)8 * 128 * 128 * 2;
constexpr size_t OFF_WIN = 0, OFF_WPA = OFF_WIN + SZ_WIN, OFF_WPB = OFF_WPA + SZ_WP, OFF_WOUT = OFF_WPB + SZ_WP, OFF_SGW = OFF_WOUT + SZ_WOUT, SZ_LAYER_W = OFF_SGW + SZ_SGW;
constexpr size_t WS_W = 0, WS_H = WS_W + DEPTH * SZ_LAYER_W, WS_VT = WS_H + (size_t)NTOK * DM * 2, WS_PROJ = WS_VT + (size_t)2048 * NTOK * 2,
                 WS_BAR = WS_PROJ + (size_t)NTOK * NP * 2, WS_KT = WS_BAR + 16384, WS_END = WS_KT + (size_t)NTOK * 1024 * 2;
constexpr int LDS_BYTES = 131072 + 64;

struct Params {
    const float* x; const float* pre_g; const float* post_g; const float* w_in; const float* rpb; const float* ln_g; const float* ln_b;
    const float* sg_w; const float* sg_b; const float* w_pa; const float* w_pb; const float* w_out; float* out; unsigned char* ws;
};

__device__ __forceinline__ unsigned f2bf(float f) { unsigned u = __builtin_bit_cast(unsigned, f); return (u + 0x7fffu + ((u >> 16) & 1u)) >> 16; }
__device__ __forceinline__ unsigned cvt_pk_bf16(float lo, float hi) { unsigned r; asm volatile("v_cvt_pk_bf16_f32 %0, %1, %2" : "=v"(r) : "v"(lo), "v"(hi)); return r; }
__device__ __forceinline__ float bflo(unsigned w) { return __builtin_bit_cast(float, w << 16); }
__device__ __forceinline__ float bfhi(unsigned w) { return __builtin_bit_cast(float, w & 0xffff0000u); }
__device__ __forceinline__ float sigmoidf_(float v) { return __builtin_amdgcn_rcpf(1.0f + __expf(-v)); }
__device__ __forceinline__ float siluf_(float v) { return v * sigmoidf_(v); }

namespace pg8 {
constexpr int BM = 256, BK = 64, HALF = 128, HTB = HALF * BK * 2, STAGE_BYTES = 8 * HTB, NXCD = 8, WGM = 8;
__host__ __device__ __forceinline__ int lds_byte(int r, int c) { const int st = (r >> 4) * 2 + (c >> 5), rr = r & 15, cc = c & 31, ob = rr * 64 + cc * 2; return st * 1024 + (ob ^ (((ob >> 9) & 1) << 5)); }
__host__ __device__ __forceinline__ void stage_rc(int b, int& R, int& C) { const int st = b / 1024, sb = b % 1024, swz = sb ^ (((sb >> 9) & 1) << 5); R = (st >> 1) * 16 + swz / 64; C = (st & 1) * 32 + (swz % 64) / 2; }
__host__ __device__ __forceinline__ int perm32(int rho) { const int n = rho >> 4, i = rho & 15; return 8 * (i >> 2) + 4 * n + (i & 3); }

struct Unit { int pm, pn; };
struct Gemm { const bf16_t* A; const bf16_t* Bt; int M, N, K, lda, ldb; };

struct StaticOrder {
    int nM, nN, nwg, G, c;
    __device__ void init(int M, int N, int G_, int c_) { nM = M / BM; nN = N / BM; nwg = nM * nN; G = G_; c = c_; }
    __device__ bool next(int i, Unit& u) const {
        const long L = (long)i * G + c; if (L >= nwg) return false;
        int wgid = (int)L; { const int q = nwg / NXCD, r = nwg % NXCD, xcd = wgid % NXCD, off = wgid / NXCD; wgid = (xcd < r ? xcd * (q + 1) : r * (q + 1) + (xcd - r) * q) + off; }
        const int nig = WGM * nN, gid = wgid / nig, fm = gid * WGM, gsz = (nM - fm) < WGM ? (nM - fm) : WGM;
        u.pm = fm + ((wgid % nig) % gsz); u.pn = (wgid % nig) / gsz; return true;
    }
};

struct Epi {
    int mode;
    bf16_t* obf; int ldo;
    int sigcol;
    bf16_t* kt;
    const bf16_t* gate; int ldg;
    __device__ __forceinline__ void operator()(const f32x4 (&acc)[2][2][4][2], const Unit& u, int wr, int wc, int fr, int fq) const {
        const int row0 = u.pm * BM + wr * 64 + fr, col0 = u.pn * BM + wc * 32 + 8 * fq;
        if (mode == 2) {
#pragma unroll
            for (int ai = 0; ai < 2; ++ai) {
                u32x4 GB[4][2];
#pragma unroll
                for (int m = 0; m < 4; ++m)
#pragma unroll
                    for (int bj = 0; bj < 2; ++bj) GB[m][bj] = *(const u32x4*)(gate + (size_t)(row0 + ai * HALF + m * 16) * ldg + col0 + bj * HALF + 2048);
                __builtin_amdgcn_sched_barrier(0);
#pragma unroll
                for (int m = 0; m < 4; ++m)
#pragma unroll
                    for (int bj = 0; bj < 2; ++bj) {
                        const u32x4 g = GB[m][bj]; f32x4 v0 = acc[ai][bj][m][0], v1 = acc[ai][bj][m][1];
                        v0[0] *= bflo(g.x); v0[1] *= bfhi(g.x); v0[2] *= bflo(g.y); v0[3] *= bfhi(g.y); v1[0] *= bflo(g.z); v1[1] *= bfhi(g.z); v1[2] *= bflo(g.w); v1[3] *= bfhi(g.w);
                        u32x4 w; w.x = cvt_pk_bf16(v0[0], v0[1]); w.y = cvt_pk_bf16(v0[2], v0[3]); w.z = cvt_pk_bf16(v1[0], v1[1]); w.w = cvt_pk_bf16(v1[2], v1[3]);
                        *(u32x4*)(obf + (size_t)(row0 + ai * HALF + m * 16) * ldo + col0 + bj * HALF) = w;
                    }
                __builtin_amdgcn_sched_barrier(0);
            }
            return;
        }
        if ((mode == 0) && (u.pn * BM >= sigcol)) {
            const int c0 = sigcol + (u.pn - sigcol / BM) * HALF + wc * 32 + 8 * fq;
#pragma unroll
            for (int ai = 0; ai < 2; ++ai)
#pragma unroll
                for (int m = 0; m < 4; ++m) {
                    const size_t row = (size_t)(row0 + ai * HALF + m * 16);
                    float rr[8], sb[8];
#pragma unroll
                    for (int e = 0; e < 8; ++e) { const float ga = acc[ai][0][m][e >> 2][e & 3], gb = acc[ai][1][m][e >> 2][e & 3];
                        const float eb = 1.0f + __expf(-gb); sb[e] = __builtin_amdgcn_rcpf(eb); rr[e] = eb * __builtin_amdgcn_rcpf(1.0f + __expf(-ga)); }
                    u32x4 w; w.x = cvt_pk_bf16(rr[0], rr[1]); w.y = cvt_pk_bf16(rr[2], rr[3]); w.z = cvt_pk_bf16(rr[4], rr[5]); w.w = cvt_pk_bf16(rr[6], rr[7]);
                    __builtin_nontemporal_store(w, (u32x4*)(obf + row * ldo + c0));
                    w.x = cvt_pk_bf16(sb[0], sb[1]); w.y = cvt_pk_bf16(sb[2], sb[3]); w.z = cvt_pk_bf16(sb[4], sb[5]); w.w = cvt_pk_bf16(sb[6], sb[7]);
                    __builtin_nontemporal_store(w, (u32x4*)(obf + row * ldo + c0 + 2048));
                }
            return;
        }
        const bool sg = false;
        const bool ktile = (mode == 0) && (kt != nullptr) && (u.pn >= 4) && (u.pn < 8);
#pragma unroll
        for (int ai = 0; ai < 2; ++ai)
#pragma unroll
            for (int m = 0; m < 4; ++m) {
                const size_t row = (size_t)(row0 + ai * HALF + m * 16);
#pragma unroll
                for (int bj = 0; bj < 2; ++bj) {
                    const int col = col0 + bj * HALF;
                    f32x4 v0 = acc[ai][bj][m][0], v1 = acc[ai][bj][m][1];
                    if (sg) {
#pragma unroll
                        for (int e = 0; e < 4; ++e) { v0[e] = sigmoidf_(v0[e]); v1[e] = sigmoidf_(v1[e]); }
                    }
                    u32x4 w; w.x = cvt_pk_bf16(v0[0], v0[1]); w.y = cvt_pk_bf16(v0[2], v0[3]); w.z = cvt_pk_bf16(v1[0], v1[1]); w.w = cvt_pk_bf16(v1[2], v1[3]);
                    if (ktile) *(u32x4*)(kt + (((row >> 6) * 8 + (size_t)((u.pn - 4) * 2 + bj)) * 64 + (row & 63)) * 128 + (wc * 32 + 8 * fq)) = w;
                    else if (mode == 0) *(u32x4*)(obf + row * ldo + col) = w;
                    else *(u32x4*)(obf + ((size_t)(col >> 6) * 2048 + row) * 64 + (col & 63)) = w;
                }
            }
    }
    __device__ __forceinline__ void mid(f32x4 (&acc)[2][2][4][2], const Unit& u, int wr, int wc, int fr, int fq) const {
        int row0 = u.pm * BM + wr * 64 + fr, col0 = u.pn * BM + wc * 32 + 8 * fq;
        asm volatile("" : "+v"(row0), "+v"(col0));
        u32x4 RT[2][4][2];
#pragma unroll
        for (int ai = 0; ai < 2; ++ai)
#pragma unroll
            for (int m = 0; m < 4; ++m)
#pragma unroll
                for (int bj = 0; bj < 2; ++bj) RT[ai][m][bj] = *(const u32x4*)(gate + (size_t)(row0 + ai * HALF + m * 16) * ldg + col0 + bj * HALF);
        __builtin_amdgcn_sched_barrier(0);
#pragma unroll
        for (int ai = 0; ai < 2; ++ai)
#pragma unroll
            for (int m = 0; m < 4; ++m)
#pragma unroll
                for (int bj = 0; bj < 2; ++bj) {
                    const unsigned rw[4] = {RT[ai][m][bj].x, RT[ai][m][bj].y, RT[ai][m][bj].z, RT[ai][m][bj].w};
#pragma unroll
                    for (int i = 0; i < 4; ++i) { acc[ai][bj][m][i >> 1][(i & 1) * 2] *= bflo(rw[i]); acc[ai][bj][m][i >> 1][(i & 1) * 2 + 1] *= bfhi(rw[i]); }
                }
        __builtin_amdgcn_sched_barrier(0);
    }
};

__device__ __forceinline__ void gemm_phase(LAS unsigned char* lds, const Gemm g, const StaticOrder& S, const Epi& E, const int tid) {
    const int wid = __builtin_amdgcn_readfirstlane(tid >> 6), lane = tid & 63, wr = wid >> 2, wc = wid & 3, fr = lane & 15, fq = lane >> 4;
    const int K = g.K, nt = K / BK;
    unsigned voffA[2], voffB[2];
#pragma unroll
    for (int i = 0; i < 2; ++i) { int R, C; stage_rc(tid * 16 + i * 8192, R, C); const int Rb = (R & ~31) + perm32(R & 31);
        voffA[i] = (unsigned)(R * g.lda + C) * 2u; voffB[i] = (unsigned)(Rb * g.ldb + C) * 2u; }
    const size_t kstep = (size_t)(BK * 2);
    const size_t hstepA = (size_t)HALF * g.lda * 2, hstepB = (size_t)HALF * g.ldb * 2;
    const size_t tstepA = 2 * hstepA, tstepB = 2 * hstepB;
    const unsigned ldsw = (unsigned)wid * 1024u;
    const int aoff = lds_byte(wr * 64 + fr, fq * 8), boff = lds_byte(wc * 32 + fr, fq * 8);
#define PG8_SA(b, h) (((b) * 2 + (h)) * HTB)
#define PG8_SB(b, h) ((4 + (b) * 2 + (h)) * HTB)
#define PG8_STAGE(bufoff, gbase, voff) do { _Pragma("unroll") for (int _i = 0; _i < 2; ++_i) \
        __builtin_amdgcn_global_load_lds((const unsigned*)((const char*)(gbase) + (voff)[_i]), (LAS unsigned*)(lds + (bufoff) + ldsw + _i * 8192), 16, 0, 0); } while (0)
#define PG8_LDA(dst, b, h) do { _Pragma("unroll") for (int m = 0; m < 4; ++m) _Pragma("unroll") for (int k = 0; k < 2; ++k) dst[m][k] = *(const LAS bf16x8*)(lds + PG8_SA(b, h) + aoff + m * 2048 + k * 1024); } while (0)
#define PG8_LDB(dst, b, h) do { _Pragma("unroll") for (int n = 0; n < 2; ++n) _Pragma("unroll") for (int k = 0; k < 2; ++k) dst[n][k] = *(const LAS bf16x8*)(lds + PG8_SB(b, h) + boff + n * 2048 + k * 1024); } while (0)
#define PG8_MMA(ai, bj, At, Bt) do { __builtin_amdgcn_s_setprio(1); _Pragma("unroll") for (int m = 0; m < 4; ++m) _Pragma("unroll") for (int n = 0; n < 2; ++n) _Pragma("unroll") for (int k = 0; k < 2; ++k) \
        acc[ai][bj][m][n] = __builtin_amdgcn_mfma_f32_16x16x32_bf16(Bt[n][k], At[m][k], acc[ai][bj][m][n], 0, 0, 0); __builtin_amdgcn_s_setprio(0); } while (0)
#define PG8_WAIT_V(n) asm volatile("s_waitcnt vmcnt(" #n ")" ::: "memory")
#define PG8_WAIT_L(n) asm volatile("s_waitcnt lgkmcnt(" #n ")" ::: "memory")
#define PG8_BAR __builtin_amdgcn_s_barrier()
#define PG8_SCHED __builtin_amdgcn_sched_barrier(0)
    Unit cur, nxt; int ui = 0;
    if (!S.next(0, cur)) return;
    f32x4 acc[2][2][4][2];
#pragma unroll
    for (int a = 0; a < 2; ++a)
#pragma unroll
        for (int b = 0; b < 2; ++b)
#pragma unroll
            for (int m = 0; m < 4; ++m)
#pragma unroll
                for (int n = 0; n < 2; ++n) acc[a][b][m][n] = (f32x4){0.f, 0.f, 0.f, 0.f};
    bf16x8 At[4][2], B0[2][2], B1[2][2];
    const char* cA = (const char*)g.A + (size_t)cur.pm * tstepA; const char* cB = (const char*)g.Bt + (size_t)cur.pn * tstepB;
    PG8_STAGE(PG8_SB(0, 0), cB, voffB); PG8_STAGE(PG8_SB(0, 1), cB + hstepB, voffB); PG8_STAGE(PG8_SA(0, 0), cA, voffA); PG8_STAGE(PG8_SA(0, 1), cA + hstepA, voffA);
    if (wr == 1) PG8_BAR;
    PG8_WAIT_V(2); PG8_BAR;
    PG8_STAGE(PG8_SB(1, 0), cB + kstep, voffB); PG8_STAGE(PG8_SA(1, 0), cA + kstep, voffA); PG8_STAGE(PG8_SB(1, 1), cB + hstepB + kstep, voffB);
    PG8_WAIT_V(6); PG8_BAR;
    for (;;) {
        const bool has_next = S.next(ui + 1, nxt);
        const char* nA = has_next ? (const char*)g.A + (size_t)nxt.pm * tstepA : cA; const char* nB = has_next ? (const char*)g.Bt + (size_t)nxt.pn * tstepB : cB;
        for (int t = 0; t < nt; t += 2) {
            if (E.mode == 2 && t == (nt >> 1)) E.mid(acc, cur, wr, wc, fr, fq);
            const bool last = (t == nt - 2);
            const char* a1 = cA + (size_t)(t + 1) * kstep;
            const char* a2 = last ? nA : cA + (size_t)(t + 2) * kstep; const char* b2 = last ? nB : cB + (size_t)(t + 2) * kstep;
            const char* a3 = a2 + kstep; const char* b3 = b2 + kstep;
            PG8_LDB(B0, 0, 0); PG8_LDB(B1, 0, 1); PG8_SCHED; PG8_LDA(At, 0, 0); PG8_STAGE(PG8_SA(1, 1), a1 + hstepA, voffA);
            PG8_WAIT_V(8); PG8_WAIT_L(0); PG8_BAR; PG8_MMA(0, 0, At, B0); PG8_MMA(0, 1, At, B1); PG8_BAR; PG8_SCHED;
            PG8_LDA(At, 0, 1); PG8_STAGE(PG8_SB(0, 0), b2, voffB); PG8_STAGE(PG8_SB(0, 1), b2 + hstepB, voffB); PG8_STAGE(PG8_SA(0, 0), a2, voffA);
            PG8_WAIT_V(8); PG8_WAIT_L(0); PG8_BAR; PG8_MMA(1, 0, At, B0); PG8_MMA(1, 1, At, B1); PG8_BAR; PG8_SCHED;
            PG8_LDB(B0, 1, 0); PG8_LDB(B1, 1, 1); PG8_SCHED; PG8_LDA(At, 1, 0); PG8_STAGE(PG8_SA(0, 1), a2 + hstepA, voffA);
            PG8_WAIT_V(8); PG8_WAIT_L(0); PG8_BAR; PG8_MMA(0, 0, At, B0); PG8_MMA(0, 1, At, B1); PG8_BAR; PG8_SCHED;
            PG8_LDA(At, 1, 1); PG8_STAGE(PG8_SB(1, 0), b3, voffB); PG8_STAGE(PG8_SB(1, 1), b3 + hstepB, voffB); PG8_STAGE(PG8_SA(1, 0), a3, voffA);
            PG8_WAIT_V(8); PG8_WAIT_L(0); PG8_BAR; PG8_MMA(1, 0, At, B0); PG8_MMA(1, 1, At, B1); PG8_BAR; PG8_SCHED;
        }
        if (wr == 0) PG8_BAR;
        E(acc, cur, wr, wc, fr, fq);
#ifdef EPI2
        __builtin_amdgcn_sched_barrier(0); E(acc, cur, wr, wc, fr, fq);
#endif
        if (!has_next) break;
#pragma unroll
        for (int a = 0; a < 2; ++a)
#pragma unroll
            for (int b = 0; b < 2; ++b)
#pragma unroll
                for (int m = 0; m < 4; ++m)
#pragma unroll
                    for (int n = 0; n < 2; ++n) acc[a][b][m][n] = (f32x4){0.f, 0.f, 0.f, 0.f};
        cur = nxt; cA = nA; cB = nB; ++ui;
        if (wr == 1) PG8_BAR;
    }
    PG8_WAIT_V(0);
    PG8_BAR;
#undef PG8_SA
#undef PG8_SB
#undef PG8_STAGE
#undef PG8_LDA
#undef PG8_LDB
#undef PG8_MMA
#undef PG8_WAIT_V
#undef PG8_WAIT_L
#undef PG8_BAR
#undef PG8_SCHED
}
}

__device__ __forceinline__ void convert_tile(const float* W, bf16_t* Wt, int K, int N, int k0, int n0, int orow0, LAS bf16_t* tl, const int tid, int ldw, int kofs) {
    { const int kk = tid >> 4, n4 = (tid & 15) * 4;
#pragma unroll
      for (int h = 0; h < 2; ++h) { const int k = kk + 32 * h; const f32x4 v = *(const f32x4*)(W + (size_t)(k0 + k) * N + n0 + n4);
#pragma unroll
          for (int e = 0; e < 4; ++e) tl[(n4 + e) * 72 + k] = (bf16_t)f2bf(v[e]); } }
    __syncthreads();
    { const int n = tid >> 3, ks = (tid & 7) * 8; const u32x4 w = *(const LAS u32x4*)(tl + n * 72 + ks);
      *(u32x4*)(Wt + (size_t)(orow0 + n) * ldw + kofs + k0 + ks) = w; }
    __syncthreads();
}
__device__ __forceinline__ int win_row(int n0) {
    const int seg = n0 >> 10, r = n0 & 1023;
    switch (seg) { case 0: return r; case 1: return 1024 + r; case 2: return 9216 + r; case 3: return 2048 + r; case 4: return 3072 + r; case 5: return 10240 + r; case 6: return 4096 + r;
                   case 7: case 8: { const int c = n0 - 7168; return 5120 + (c >> 7) * 256 + (c & 127); }
                   default: { const int c = n0 - 9216; return 5120 + (c >> 7) * 256 + 128 + (c & 127); } }
}

__device__ __forceinline__ void rms_rows(const float* x, const float* g, bf16_t* H, const int tid) {
    const int wid = tid >> 6, lane = tid & 63, step = gridDim.x * 8;
    int row = blockIdx.x * 8 + wid;
    f32x4 v[8], vn[8], gg[8];
#pragma unroll
    for (int i = 0; i < 8; ++i) gg[i] = *(const f32x4*)(g + i * 256 + lane * 4);
    if (row < NTOK) {
#pragma unroll
        for (int i = 0; i < 8; ++i) v[i] = __builtin_nontemporal_load((const f32x4*)(x + (size_t)row * DM + i * 256 + lane * 4)); }
    for (; row < NTOK; row += step) {
        const int nrow = row + step;
        if (nrow < NTOK) {
#pragma unroll
            for (int i = 0; i < 8; ++i) vn[i] = __builtin_nontemporal_load((const f32x4*)(x + (size_t)nrow * DM + i * 256 + lane * 4)); }
        float ss = 0.f;
#pragma unroll
        for (int i = 0; i < 8; ++i) ss += v[i][0] * v[i][0] + v[i][1] * v[i][1] + v[i][2] * v[i][2] + v[i][3] * v[i][3];
#pragma unroll
        for (int o = 32; o > 0; o >>= 1) ss += __shfl_xor(ss, o);
        const float rstd = __builtin_amdgcn_rsqf(ss * (1.0f / DM) + 1e-6f);
#pragma unroll
        for (int i = 0; i < 8; ++i) {
            u32x2 w; w.x = cvt_pk_bf16(v[i][0] * rstd * gg[i][0], v[i][1] * rstd * gg[i][1]); w.y = cvt_pk_bf16(v[i][2] * rstd * gg[i][2], v[i][3] * rstd * gg[i][3]);
            *(u32x2*)(H + (size_t)row * DM + i * 256 + lane * 4) = w; }
#pragma unroll
        for (int i = 0; i < 8; ++i) v[i] = vn[i];
    }
}

__device__ __forceinline__ void post_rows(const float* xin, const bf16_t* OUT, const float* pg, float* out, const float* ng, bf16_t* H, const int tid) {
    const int wid = tid >> 6, lane = tid & 63, step = gridDim.x * 8;
    int row = blockIdx.x * 8 + wid;
    u32x2 ow[8], own[8]; f32x4 xw[8], xwn[8], pgv[8], ngv[8];
#pragma unroll
    for (int i = 0; i < 8; ++i) { pgv[i] = *(const f32x4*)(pg + i * 256 + lane * 4); ngv[i] = ng ? *(const f32x4*)(ng + i * 256 + lane * 4) : (f32x4){0.f, 0.f, 0.f, 0.f}; }
    if (row < NTOK) {
#pragma unroll
        for (int i = 0; i < 8; ++i) { ow[i] = __builtin_nontemporal_load((const u32x2*)(OUT + (size_t)row * DM + i * 256 + lane * 4)); xw[i] = __builtin_nontemporal_load((const f32x4*)(xin + (size_t)row * DM + i * 256 + lane * 4)); } }
    for (; row < NTOK; row += step) {
        const int nrow = row + step;
        if (nrow < NTOK) {
#pragma unroll
            for (int i = 0; i < 8; ++i) { own[i] = __builtin_nontemporal_load((const u32x2*)(OUT + (size_t)nrow * DM + i * 256 + lane * 4)); xwn[i] = __builtin_nontemporal_load((const f32x4*)(xin + (size_t)nrow * DM + i * 256 + lane * 4)); } }
        f32x4 o[8]; float ss = 0.f;
#pragma unroll
        for (int i = 0; i < 8; ++i) { const u32x2 w = ow[i];
            o[i][0] = bflo(w.x); o[i][1] = bfhi(w.x); o[i][2] = bflo(w.y); o[i][3] = bfhi(w.y); ss += o[i][0] * o[i][0] + o[i][1] * o[i][1] + o[i][2] * o[i][2] + o[i][3] * o[i][3]; }
#pragma unroll
        for (int s = 32; s > 0; s >>= 1) ss += __shfl_xor(ss, s);
        const float rstd = __builtin_amdgcn_rsqf(ss * (1.0f / DM) + 1e-6f);
        float s2 = 0.f;
#pragma unroll
        for (int i = 0; i < 8; ++i) { const f32x4 gg = pgv[i]; const f32x4 xv = xw[i];
            f32x4 r; r[0] = xv[0] + o[i][0] * rstd * gg[0]; r[1] = xv[1] + o[i][1] * rstd * gg[1]; r[2] = xv[2] + o[i][2] * rstd * gg[2]; r[3] = xv[3] + o[i][3] * rstd * gg[3];
            *(f32x4*)(out + (size_t)row * DM + i * 256 + lane * 4) = r; o[i] = r; s2 += r[0] * r[0] + r[1] * r[1] + r[2] * r[2] + r[3] * r[3]; }
        if (ng) {
#pragma unroll
            for (int s = 32; s > 0; s >>= 1) s2 += __shfl_xor(s2, s);
            const float rs2 = __builtin_amdgcn_rsqf(s2 * (1.0f / DM) + 1e-6f);
#pragma unroll
            for (int i = 0; i < 8; ++i) { const f32x4 gg = ngv[i];
                u32x2 w; w.x = cvt_pk_bf16(o[i][0] * rs2 * gg[0], o[i][1] * rs2 * gg[1]); w.y = cvt_pk_bf16(o[i][2] * rs2 * gg[2], o[i][3] * rs2 * gg[3]);
                *(u32x2*)(H + (size_t)row * DM + i * 256 + lane * 4) = w; }
        }
#pragma unroll
        for (int i = 0; i < 8; ++i) { ow[i] = own[i]; xw[i] = xwn[i]; }
    }
}

constexpr int NA_SLOT = 18432;
constexpr int NA_RPB_OFF = 3 * NA_SLOT;
#define NA_BAR() do { asm volatile("s_waitcnt lgkmcnt(0)" ::: "memory"); __builtin_amdgcn_s_barrier(); asm volatile("" ::: "memory"); } while (0)

struct NaUnit { int b, r0, head, rsA, delta; };
__device__ __forceinline__ NaUnit na_decode(int u) {
    NaUnit n; const int cc = u & 255, idx = cc >> 3; n.head = u >> 8; n.b = idx >> 4; n.r0 = 2 * ((cc & 7) * 16 + (idx & 15));
    n.rsA = min(max(n.r0 - 4, 0), 248); n.delta = min(max(n.r0 - 3, 0), 248) - n.rsA; return n; }

template <int I> __device__ __forceinline__ void na_issue(u32x4 (&R)[2], const bf16_t* KT, const bf16_t* VT, const NaUnit& n, const int tid) {
    if constexpr (I < 9) {
        const int row = min(n.rsA + I, 255);
        const bf16_t* base = KT + ((size_t)((n.b * 256 + row) * 8 + n.head)) * 8192 + tid * 8;
        R[0] = *(const u32x4*)base; R[1] = *(const u32x4*)(base + 4096);
    } else {
        const int row = min(n.rsA + (I - 9), 255);
        const bf16_t* base = VT + ((size_t)((n.b * 256 + row) * 2048 + n.head * 128)) * 64 + tid * 8;
        R[0] = *(const u32x4*)base; R[1] = *(const u32x4*)(base + 4096);
    }
}
template <int I> __device__ __forceinline__ void na_write(const u32x4 (&R)[2], LAS unsigned char* ring, const int tid) {
    LAS unsigned char* slot = ring + (I % 3) * NA_SLOT;
    if constexpr (I < 9) { LAS unsigned char* d = slot + (tid >> 4) * 288 + (tid & 15) * 16; *(LAS u32x4*)d = R[0]; *(LAS u32x4*)(d + 32 * 288) = R[1]; }
    else { LAS unsigned char* d = slot + (tid >> 3) * 144 + (tid & 7) * 16; *(LAS u32x4*)d = R[0]; *(LAS u32x4*)(d + 64 * 144) = R[1]; }
}

struct NaState { f32x4 s[8][2]; bf16x8 pf[8]; f32x4 o[8]; bf16x8 qf[4]; u32x2 z[8]; float inv; int idx[4]; bool sel[4]; unsigned m01, m23; };

template <int T> __device__ __forceinline__ void na_kstep(NaState& st, const LAS unsigned char* ring, int shift, int kc0, int fr, int fq) {
    const LAS unsigned char* base = ring + ((T + shift) % 3) * NA_SLOT + (kc0 + fr) * 288 + fq * 16;
    bf16x8 kf[2][4];
#pragma unroll
    for (int ct = 0; ct < 2; ++ct)
#pragma unroll
        for (int ks = 0; ks < 4; ++ks) kf[ct][ks] = *(const LAS bf16x8*)(base + ct * 16 * 288 + ks * 64);
    __builtin_amdgcn_sched_barrier(0);
    f32x4 a0 = {0.f, 0.f, 0.f, 0.f}, a1 = {0.f, 0.f, 0.f, 0.f};
#pragma unroll
    for (int ks = 0; ks < 4; ++ks) { a0 = __builtin_amdgcn_mfma_f32_16x16x32_bf16(kf[0][ks], st.qf[ks], a0, 0, 0, 0); a1 = __builtin_amdgcn_mfma_f32_16x16x32_bf16(kf[1][ks], st.qf[ks], a1, 0, 0, 0); }
    st.s[T][0] = a0; st.s[T][1] = a1;
}
template <int T> __device__ __forceinline__ void na_vstep(NaState& st, const LAS unsigned char* ring, int shift, int kc0, int fr, int fq) {
    const LAS unsigned char* vp = ring + ((9 + T + shift) % 3) * NA_SLOT + fr * 144 + (kc0 + 4 * fq) * 2;
    unsigned vph = (unsigned)(size_t)vp + 32u; asm volatile("" : "+v"(vph));
    const LAS unsigned char* vp2 = (const LAS unsigned char*)(size_t)vph;
    u32x2 lo[8], hi[8];
#pragma unroll
    for (int dt = 0; dt < 8; ++dt) { lo[dt] = *(const LAS u32x2*)(vp + dt * 16 * 144); hi[dt] = *(const LAS u32x2*)(vp2 + dt * 16 * 144); }
    __builtin_amdgcn_sched_barrier(0);
#pragma unroll
    for (int dt = 0; dt < 8; ++dt) {
        u32x4 w; w.x = lo[dt].x; w.y = lo[dt].y; w.z = hi[dt].x; w.w = hi[dt].y;
        st.o[dt] = __builtin_amdgcn_mfma_f32_16x16x32_bf16(__builtin_bit_cast(bf16x8, w), st.pf[T], st.o[dt], 0, 0, 0);
    }
}
__device__ __forceinline__ void na_softmax(NaState& st, const LAS float* rp, int head, int drow0) {
    const float scale2 = 0.08838834764831845f * 1.4426950408889634f;
    float mx = -1e30f;
#pragma unroll
    for (int ki = 0; ki < 8; ++ki) {
        const LAS float* row = rp + (head * 15 + drow0 + ki) * 32;
#pragma unroll
        for (int j = 0; j < 4; ++j) { const float sv = st.sel[j] ? st.s[ki][0][j] : st.s[ki][1][j]; const float v = __builtin_fmaf(sv, scale2, row[st.idx[j]]); st.s[ki][0][j] = v; mx = fmaxf(mx, v); }
    }
    mx = fmaxf(mx, __shfl_xor(mx, 16)); mx = fmaxf(mx, __shfl_xor(mx, 32));
    float sum = 0.f;
    const unsigned m01 = st.m01, m23 = st.m23;
#pragma unroll
    for (int ki = 0; ki < 8; ++ki) {
        float e[4];
#pragma unroll
        for (int j = 0; j < 4; ++j) { e[j] = __builtin_amdgcn_exp2f(st.s[ki][0][j] - mx); sum += e[j]; }
        const unsigned p01 = cvt_pk_bf16(e[0], e[1]), p23 = cvt_pk_bf16(e[2], e[3]);
        u32x4 w; w.x = p01 & m01; w.y = p23 & m23; w.z = p01 & ~m01; w.w = p23 & ~m23;
        st.pf[ki] = __builtin_bit_cast(bf16x8, w);
    }
    sum += __shfl_xor(sum, 16); sum += __shfl_xor(sum, 32);
    st.inv = 1.0f / sum;
#pragma unroll
    for (int dt = 0; dt < 8; ++dt) st.o[dt] = (f32x4){0.f, 0.f, 0.f, 0.f};
}

template <int skip> __device__ __forceinline__ void na_phase(const Params& p, int layer, LAS unsigned char* lds, const int tid) {
    LAS float* rp = (LAS float*)(lds + NA_RPB_OFF);
    for (int i = tid; i < 8 * 15 * 32; i += 512) { const int rw = i >> 5, cl = i & 31; rp[i] = (cl < 31) ? p.rpb[layer * RPB_N + rw * 31 + cl] * 1.4426950408889634f : -1e30f; }
    const bf16_t* PROJ = (const bf16_t*)(p.ws + WS_PROJ); const bf16_t* VT = (const bf16_t*)(p.ws + WS_VT); bf16_t* Y = (bf16_t*)(p.ws + WS_H); const bf16_t* KT = (const bf16_t*)(p.ws + WS_KT);
    const int wid = __builtin_amdgcn_readfirstlane(tid >> 6), lane = tid & 63, fr = lane & 15, fq = lane >> 4, ri = wid >> 2, qb = wid & 3;
    const int kc0 = (qb == 0) ? 0 : (qb == 1) ? 8 : (qb == 2) ? 24 : 32, qcol = 16 * qb + fr;
    const int G = (int)gridDim.x, c = (int)blockIdx.x;
    if (c >= 2048) { __syncthreads(); return; }
    LAS unsigned char* ring = lds;
    NaState st; u32x4 R0[2], R1[2], R2[2], R3[2], R4[2], R5[2];
    { const int cs = min(max(qcol - 8, 0), 48); unsigned m01 = 0u, m23 = 0u;
#pragma unroll
      for (int j = 0; j < 4; ++j) { const int k0 = kc0 + 4 * fq + j; const bool v0 = (k0 >= cs) && (k0 < cs + 16);
          st.sel[j] = v0; st.idx[j] = (v0 ? k0 : k0 + 16) - qcol + 15;
          if (v0) { if (j == 0) m01 |= 0xffffu; if (j == 1) m01 |= 0xffff0000u; if (j == 2) m23 |= 0xffffu; if (j == 3) m23 |= 0xffff0000u; } }
      st.m01 = m01; st.m23 = m23; }
    NaUnit cur = na_decode(c);
    na_issue<0>(R0, KT, VT, cur, tid); na_issue<1>(R1, KT, VT, cur, tid); na_issue<2>(R2, KT, VT, cur, tid);
    na_issue<3>(R3, KT, VT, cur, tid); na_issue<4>(R4, KT, VT, cur, tid); na_issue<5>(R5, KT, VT, cur, tid);
    { const size_t qtok = (size_t)(cur.b * SEQ + (cur.r0 + ri) * 64 + qcol);
#pragma unroll
      for (int ks = 0; ks < 4; ++ks) st.qf[ks] = *(const bf16x8*)(PROJ + qtok * NP + Q_OFF + cur.head * 128 + ks * 32 + fq * 8); }
    for (int u = c; u < 2048; u += G) {
        const bool has_next = (u + G) < 2048;
        const NaUnit nxt = has_next ? na_decode(u + G) : cur;
        const int my_r = cur.r0 + ri, shift = ri ? cur.delta : 0, head = cur.head;
        const size_t qtok = (size_t)(cur.b * SEQ + my_r * 64 + qcol);
#define NA_PUT(I, RR, NU, NI) do { if constexpr (!(skip & 8)) { na_write<I>(RR, ring, tid); na_issue<NI>(RR, KT, VT, NU, tid); } } while (0)
        NA_BAR();
        NA_PUT(0, R0, cur, 6); NA_PUT(1, R1, cur, 7);   NA_BAR(); if constexpr (!(skip & 1)) na_kstep<0>(st, ring, shift, kc0, fr, fq);
        NA_PUT(2, R2, cur, 8);                          NA_BAR(); if constexpr (!(skip & 1)) na_kstep<1>(st, ring, shift, kc0, fr, fq);
        NA_PUT(3, R3, cur, 9);                          NA_BAR(); if constexpr (!(skip & 1)) na_kstep<2>(st, ring, shift, kc0, fr, fq);
        NA_PUT(4, R4, cur, 10);                          NA_BAR(); if constexpr (!(skip & 1)) na_kstep<3>(st, ring, shift, kc0, fr, fq);
        NA_PUT(5, R5, cur, 11);                          NA_BAR(); if constexpr (!(skip & 1)) na_kstep<4>(st, ring, shift, kc0, fr, fq);
        NA_PUT(6, R0, cur, 12);                          NA_BAR(); if constexpr (!(skip & 1)) na_kstep<5>(st, ring, shift, kc0, fr, fq);
        NA_PUT(7, R1, cur, 13);                         NA_BAR(); if constexpr (!(skip & 1)) na_kstep<6>(st, ring, shift, kc0, fr, fq);
        NA_PUT(8, R2, cur, 14);                         NA_BAR(); if constexpr (!(skip & 1)) na_kstep<7>(st, ring, shift, kc0, fr, fq);
        if constexpr (!(skip & 2)) na_softmax(st, rp, head, (cur.rsA + shift) - my_r + 7);
        if constexpr (!(skip & 4)) {
#pragma unroll
        for (int dt = 0; dt < 8; ++dt) st.z[dt] = *(const u32x2*)(PROJ + qtok * NP + ZA_OFF + head * 128 + dt * 16 + 4 * fq); }
        NA_BAR();
        NA_PUT(9, R3, cur, 15); NA_PUT(10, R4, cur, 16); NA_BAR(); if constexpr (!(skip & 1)) na_vstep<0>(st, ring, shift, kc0, fr, fq);
        NA_PUT(11, R5, cur, 17);                         NA_BAR(); if constexpr (!(skip & 1)) na_vstep<1>(st, ring, shift, kc0, fr, fq);
        NA_PUT(12, R0, nxt, 0);                         NA_BAR(); if constexpr (!(skip & 1)) na_vstep<2>(st, ring, shift, kc0, fr, fq);
        NA_PUT(13, R1, nxt, 1);                         NA_BAR(); if constexpr (!(skip & 1)) na_vstep<3>(st, ring, shift, kc0, fr, fq);
        NA_PUT(14, R2, nxt, 2);                         NA_BAR(); if constexpr (!(skip & 1)) na_vstep<4>(st, ring, shift, kc0, fr, fq);
        { const size_t nq = (size_t)(nxt.b * SEQ + (nxt.r0 + ri) * 64 + qcol);
#pragma unroll
          for (int ks = 0; ks < 4; ++ks) st.qf[ks] = *(const bf16x8*)(PROJ + nq * NP + Q_OFF + nxt.head * 128 + ks * 32 + fq * 8); }
        NA_PUT(15, R3, nxt, 3);                          NA_BAR(); if constexpr (!(skip & 1)) na_vstep<5>(st, ring, shift, kc0, fr, fq);
        NA_PUT(16, R4, nxt, 4);                          NA_BAR(); if constexpr (!(skip & 1)) na_vstep<6>(st, ring, shift, kc0, fr, fq);
        NA_PUT(17, R5, nxt, 5);                          NA_BAR(); if constexpr (!(skip & 1)) na_vstep<7>(st, ring, shift, kc0, fr, fq);
#undef NA_PUT
        if constexpr (!(skip & 4))
#pragma unroll
        for (int dt = 0; dt < 8; ++dt) {
            const f32x4 o = st.o[dt]; const u32x2 z = st.z[dt]; const float inv = st.inv;
            u32x2 y; y.x = cvt_pk_bf16(o[0] * inv * siluf_(bflo(z.x)), o[1] * inv * siluf_(bfhi(z.x))); y.y = cvt_pk_bf16(o[2] * inv * siluf_(bflo(z.y)), o[3] * inv * siluf_(bfhi(z.y)));
            *(u32x2*)(Y + qtok * DM + head * 128 + dt * 16 + 4 * fq) = y;
        }
        cur = nxt;
    }
    __syncthreads();
}

struct SgPre { u32x4 vs[4]; u32x2 u[8], z[8]; float bb[8]; float lg, lb; };
__device__ __forceinline__ void sg_fetch(SgPre& P, u32x4 (&WR)[4], const char* PROJ, const char* VT, const char* Wsb, const float* lng, const float* lnb, const float* bs,
                                         int chunk, int g, int wid, int fr, int fq, int tid) {
    const int ch = g * 128 + 16 * wid + fr, c4 = g * 128 + 16 * wid + 4 * fq;
    const unsigned woff = (unsigned)g * 32768u + (unsigned)tid * 16u;
#pragma unroll
    for (int i = 0; i < 4; ++i) WR[i] = *(const u32x4*)(Wsb + (size_t)(woff + 8192u * i));
#pragma unroll
    for (int ks = 0; ks < 4; ++ks) { const int t0 = 32 * ks + 8 * fq; const unsigned vo = ((unsigned)((chunk * 2 + (t0 >> 6)) * 2048 + 1024 + ch) * 64u + (unsigned)(t0 & 63)) * 2u; P.vs[ks] = *(const u32x4*)(VT + (size_t)vo); }
    const unsigned uo = ((unsigned)(chunk * 128 + fr) * (unsigned)NP + (unsigned)(U_OFF + c4)) * 2u;
#pragma unroll
    for (int st = 0; st < 8; ++st) { const unsigned o = uo + (unsigned)st * (16u * NP * 2u);
        P.u[st] = *(const u32x2*)(PROJ + (size_t)o); P.z[st] = *(const u32x2*)(PROJ + (size_t)o + (ZB_OFF - U_OFF) * 2); P.bb[st] = bs[g * 128 + st * 16 + fr]; }
    P.lg = lng[ch]; P.lb = lnb[ch];
}
__device__ __forceinline__ void sg_group(const SgPre& P, const LAS unsigned char* wb, const LAS float* mu, const LAS float* rsd, char* Y, int tok0, int g, int wid, int fr, int fq) {
    const float lg = P.lg, lb = P.lb;
    bf16x8 af[4];
#pragma unroll
    for (int ks = 0; ks < 4; ++ks) {
        const int t0 = 32 * ks + 8 * fq; const u32x4 v = P.vs[ks];
        const f32x4 m0 = *(const LAS f32x4*)(mu + t0), m1 = *(const LAS f32x4*)(mu + t0 + 4), r0 = *(const LAS f32x4*)(rsd + t0), r1 = *(const LAS f32x4*)(rsd + t0 + 4);
        u32x4 w;
        w.x = cvt_pk_bf16((bflo(v.x) - m0[0]) * r0[0] * lg + lb, (bfhi(v.x) - m0[1]) * r0[1] * lg + lb);
        w.y = cvt_pk_bf16((bflo(v.y) - m0[2]) * r0[2] * lg + lb, (bfhi(v.y) - m0[3]) * r0[3] * lg + lb);
        w.z = cvt_pk_bf16((bflo(v.z) - m1[0]) * r1[0] * lg + lb, (bfhi(v.z) - m1[1]) * r1[1] * lg + lb);
        w.w = cvt_pk_bf16((bflo(v.w) - m1[2]) * r1[2] * lg + lb, (bfhi(v.w) - m1[3]) * r1[3] * lg + lb);
        af[ks] = __builtin_bit_cast(bf16x8, w);
    }
    const unsigned yo = ((unsigned)(tok0 + fr) * (unsigned)DM + (unsigned)(g * 128 + 16 * wid + 4 * fq)) * 2u;
#pragma unroll
    for (int st = 0; st < 8; ++st) {
        const LAS unsigned char* wp = wb + (st * 16 + fr) * 288 + fq * 16;
        f32x4 a = {0.f, 0.f, 0.f, 0.f};
#pragma unroll
        for (int ks = 0; ks < 4; ++ks) { const bf16x8 wf = *(const LAS bf16x8*)(wp + ks * 64); a = __builtin_amdgcn_mfma_f32_16x16x32_bf16(af[ks], wf, a, 0, 0, 0); }
        const float bb = P.bb[st]; const u32x2 uu = P.u[st], z = P.z[st];
        u32x2 y;
        y.x = cvt_pk_bf16(bflo(uu.x) * (a[0] + bb) * siluf_(bflo(z.x)), bfhi(uu.x) * (a[1] + bb) * siluf_(bfhi(z.x)));
        y.y = cvt_pk_bf16(bflo(uu.y) * (a[2] + bb) * siluf_(bflo(z.y)), bfhi(uu.y) * (a[3] + bb) * siluf_(bfhi(z.y)));
        *(u32x2*)(Y + (size_t)(yo + (unsigned)st * (16u * DM * 2u))) = y;
    }
}
__device__ __forceinline__ void sg_phase(const Params& p, int layer, LAS unsigned char* lds, const int tid) {
    LAS float* red = (LAS float*)(lds + 73728);
    LAS float* mu = (LAS float*)(lds + 73728 + 8192);
    LAS float* rsd = mu + 128;
    const char* PROJ = (const char*)(p.ws + WS_PROJ); const char* VT = (const char*)(p.ws + WS_VT); char* Y = (char*)(p.ws + WS_H) + 2048;
    const char* Wsb = (const char*)(p.ws + WS_W + layer * SZ_LAYER_W + OFF_SGW);
    const float* lng = p.ln_g + layer * 1024; const float* lnb = p.ln_b + layer * 1024; const float* bs = p.sg_b + layer * 1024;
    const int wid = __builtin_amdgcn_readfirstlane(tid >> 6), lane = tid & 63, fr = lane & 15, fq = lane >> 4;
    for (int chunk = blockIdx.x; chunk < 256; chunk += gridDim.x) {
        const int tok0 = chunk * 128;
        __syncthreads();
        SgPre P0, P1; u32x4 WR[4];
        sg_fetch(P0, WR, PROJ, VT, Wsb, lng, lnb, bs, chunk, 0, wid, fr, fq, tid);
        { const int tg = tid & 15; float s1[8], s2[8];
#pragma unroll
          for (int e = 0; e < 8; ++e) { s1[e] = 0.f; s2[e] = 0.f; }
          const unsigned vb = ((unsigned)((chunk * 2 + (tg >> 3)) * 2048 + 1024 + (tid >> 4)) * 64u + (unsigned)((tg & 7) * 8)) * 2u;
#pragma unroll 16
          for (int i = 0; i < 32; ++i) { const u32x4 v = *(const u32x4*)(VT + (size_t)(vb + (unsigned)i * 4096u));
              const unsigned w[4] = {v.x, v.y, v.z, v.w};
#pragma unroll
              for (int e = 0; e < 4; ++e) { const float f0 = bflo(w[e]), f1 = bfhi(w[e]); s1[2 * e] += f0; s1[2 * e + 1] += f1; s2[2 * e] += f0 * f0; s2[2 * e + 1] += f1 * f1; } }
#pragma unroll
          for (int e = 0; e < 8; ++e) { s1[e] += __shfl_xor(s1[e], 16); s1[e] += __shfl_xor(s1[e], 32); s2[e] += __shfl_xor(s2[e], 16); s2[e] += __shfl_xor(s2[e], 32); }
          if (lane < 16) {
#pragma unroll
              for (int e = 0; e < 8; ++e) { red[(wid * 128 + tg * 8 + e) * 2] = s1[e]; red[(wid * 128 + tg * 8 + e) * 2 + 1] = s2[e]; } } }
        NA_BAR();
        if (tid < 128) { float a = 0.f, q = 0.f;
#pragma unroll
            for (int pp = 0; pp < 8; ++pp) { a += red[(pp * 128 + tid) * 2]; q += red[(pp * 128 + tid) * 2 + 1]; }
            const float mean = a * (1.0f / 1024.f); const float var = fmaxf(q * (1.0f / 1024.f) - mean * mean, 0.f);
            mu[tid] = mean; rsd[tid] = __builtin_amdgcn_rsqf(var + 1e-5f); }
        NA_BAR();
#define SG_GROUP(G, B, PC, PN, MORE) do { \
            { LAS unsigned char* wd = lds + (B) * 36864 + (tid >> 4) * 288 + (tid & 15) * 16; \
              _Pragma("unroll") for (int i = 0; i < 4; ++i) *(LAS u32x4*)(wd + i * 32 * 288) = WR[i]; } \
            if (MORE) sg_fetch(PN, WR, PROJ, VT, Wsb, lng, lnb, bs, chunk, (G) + 1, wid, fr, fq, tid); \
            NA_BAR(); \
            sg_group(PC, lds + (B) * 36864, mu, rsd, Y, tok0, (G), wid, fr, fq); } while (0)
#pragma unroll 1
        for (int g2 = 0; g2 < 4; ++g2) { SG_GROUP(2 * g2, 0, P0, P1, true); SG_GROUP(2 * g2 + 1, 1, P1, P0, g2 < 3); }
#undef SG_GROUP
    }
}

struct CvtTile { const float* src; bf16_t* dst; int N, ldw; };
__device__ __forceinline__ CvtTile cvt_decode(const Params& p, int t) {
    constexpr int T_IN = 32 * 176, T_P = 16 * 32, T_LAYER = T_IN + 2 * T_P + 32 * 32;
    const int layer = t / T_LAYER; int r = t % T_LAYER;
    unsigned char* wl = p.ws + WS_W + layer * SZ_LAYER_W; CvtTile c;
    if (r < T_IN) { const int kt = r & 31, nt = r >> 5; c.N = NIN; c.ldw = DM; c.src = p.w_in + (size_t)layer * DM * NIN + (size_t)(kt * 64) * NIN + nt * 64; c.dst = (bf16_t*)(wl + OFF_WIN) + (size_t)win_row(nt * 64) * DM + kt * 64; }
    else if ((r -= T_IN) < T_P) { const int kt = r & 15, nt = r >> 4; c.N = DM; c.ldw = DM; c.src = p.w_pa + (size_t)layer * 1024 * DM + (size_t)(kt * 64) * DM + nt * 64; c.dst = (bf16_t*)(wl + OFF_WPA) + (size_t)(nt * 64) * DM + kt * 64; }
    else if ((r -= T_P) < T_P) { const int kt = r & 15, nt = r >> 4; c.N = DM; c.ldw = DM; c.src = p.w_pb + (size_t)layer * 1024 * DM + (size_t)(kt * 64) * DM + nt * 64; c.dst = (bf16_t*)(wl + OFF_WPA) + (size_t)(nt * 64) * DM + 1024 + kt * 64; }
    else { r -= T_P; const int kt = r & 31, nt = r >> 5; c.N = DM; c.ldw = DM; c.src = p.w_out + (size_t)layer * DM * DM + (size_t)(kt * 64) * DM + nt * 64; c.dst = (bf16_t*)(wl + OFF_WOUT) + (size_t)(nt * 64) * DM + kt * 64; }
    return c;
}
__device__ __forceinline__ void prologue(const Params& p, LAS unsigned char* lds, const int tid) {
    constexpr int T_TOTAL = DEPTH * (32 * 176 + 2 * 16 * 32 + 32 * 32);
    { const int kk = tid >> 4, n4 = (tid & 15) * 4, wn = tid >> 3, wks = (tid & 7) * 8;
      int t = blockIdx.x; f32x4 v0, v1; CvtTile cur;
      if (t < T_TOTAL) { cur = cvt_decode(p, t); v0 = __builtin_nontemporal_load((const f32x4*)(cur.src + (size_t)kk * cur.N + n4)); v1 = __builtin_nontemporal_load((const f32x4*)(cur.src + (size_t)(kk + 32) * cur.N + n4)); }
      for (int it = 0; t < T_TOTAL; t += gridDim.x, ++it) {
          LAS bf16_t* tl = (LAS bf16_t*)lds + (it & 1) * (64 * 72);
#pragma unroll
          for (int e = 0; e < 4; ++e) { tl[(n4 + e) * 72 + kk] = (bf16_t)f2bf(v0[e]); tl[(n4 + e) * 72 + kk + 32] = (bf16_t)f2bf(v1[e]); }
          const CvtTile me = cur;
          if (t + (int)gridDim.x < T_TOTAL) { cur = cvt_decode(p, t + gridDim.x); v0 = __builtin_nontemporal_load((const f32x4*)(cur.src + (size_t)kk * cur.N + n4)); v1 = __builtin_nontemporal_load((const f32x4*)(cur.src + (size_t)(kk + 32) * cur.N + n4)); }
          NA_BAR();
          const u32x4 w = *(const LAS u32x4*)(tl + wn * 72 + wks);
          *(u32x4*)(me.dst + (size_t)wn * me.ldw + wks) = w;
      }
      __syncthreads(); }
    for (int i = blockIdx.x * 512 + tid; i < DEPTH * 8 * 128 * 128 / 4; i += gridDim.x * 512) {
        const int layer = i / (8 * 128 * 128 / 4), e = i % (8 * 128 * 128 / 4);
        const f32x4 v = *(const f32x4*)(p.sg_w + (size_t)layer * 8 * 128 * 128 + e * 4);
        u32x2 w; w.x = cvt_pk_bf16(v[0], v[1]); w.y = cvt_pk_bf16(v[2], v[3]);
        *(u32x2*)((bf16_t*)(p.ws + WS_W + layer * SZ_LAYER_W + OFF_SGW) + e * 4) = w;
    }
    rms_rows(p.x, p.pre_g, (bf16_t*)(p.ws + WS_H), tid);
}

#define XB_TMO      128
#define XB_XCNT(j)  (256  + 64 * (j))
#define XB_XSUB(j)  (1280 + 64 * (j))
#define XB_XGEN(j)  (2304 + 64 * (j))
#define XB_TOP      3328
#define XB_TOPGEN   3392
#define XCD_BAR_WORDS 3456
#define XB_SPIN_CAP (1u << 22)
__device__ __forceinline__ unsigned xb_ld(unsigned* p)              { return __hip_atomic_load(p, __ATOMIC_RELAXED, __HIP_MEMORY_SCOPE_AGENT); }
__device__ __forceinline__ unsigned xb_add(unsigned* p, unsigned v) { return __hip_atomic_fetch_add(p, v, __ATOMIC_RELAXED, __HIP_MEMORY_SCOPE_AGENT); }
__device__ __forceinline__ unsigned xb_xcc_id() { return (unsigned)__builtin_amdgcn_s_getreg((3 << 11) | 20) & 0xFu; }
#define XB_SPIN(cond, bar) do { unsigned _sp = 0; while (cond) { __builtin_amdgcn_s_sleep(1); \
    if ((++_sp & 255u) == 0u) { if (xb_ld(&(bar)[XB_TMO])) break; if (_sp > XB_SPIN_CAP) { atomicAdd(&(bar)[XB_TMO], 1u); break; } } } } while (0)
__device__ __forceinline__ void xcd_barrier_complete(unsigned* bar, unsigned x, unsigned& nloc, unsigned& nx) {
    const unsigned G = gridDim.x * gridDim.y * gridDim.z;
    unsigned sum, cnt, mine, sp = 0u;
    for (;;) {
        sum = 0u; cnt = 0u; mine = 0u;
#pragma unroll
        for (unsigned j = 0; j < 16; ++j) { const unsigned c = xb_ld(&bar[XB_XCNT(j)]); sum += c; cnt += (c > 0u) ? 1u : 0u; mine = (j == x) ? c : mine; }
        if (sum == G) break;
        __builtin_amdgcn_s_sleep(1);
        if ((++sp & 255u) == 0u) { if (xb_ld(&bar[XB_TMO])) break; if (sp > XB_SPIN_CAP) { atomicAdd(&bar[XB_TMO], 1u); break; } }
    }
    nloc = mine > 0u ? mine : 1u; nx = cnt > 0u ? cnt : 1u;
}
__device__ __forceinline__ void xcd_barrier(unsigned* bar, volatile LAS unsigned* st) {
    asm volatile("s_waitcnt vmcnt(0)" ::: "memory");
    __syncthreads();
    if (threadIdx.x == 0) {
        const unsigned x = xb_xcc_id();
        __builtin_amdgcn_s_waitcnt(0);
        unsigned nloc = st[0], nx = st[1];
        if (nloc == 0u) { xcd_barrier_complete(bar, x, nloc, nx); st[0] = nloc; st[1] = nx; }
        const unsigned old = xb_add(&bar[XB_XSUB(x)], 1u);
        const unsigned gen = old / nloc;
        if (old + 1u == (gen + 1u) * nloc) {
            __builtin_amdgcn_fence(__ATOMIC_RELEASE, "agent");
            asm volatile("s_waitcnt vmcnt(0)" ::: "memory");
            const unsigned og = xb_add(&bar[XB_TOP], 1u);
            const unsigned tg = og / nx;
            if (og + 1u == (tg + 1u) * nx) xb_add(&bar[XB_TOPGEN], 1u);
            else XB_SPIN(xb_ld(&bar[XB_TOPGEN]) == tg, bar);
            __builtin_amdgcn_fence(__ATOMIC_ACQUIRE, "agent");
            xb_add(&bar[XB_XGEN(x)], 1u);
            asm volatile("s_waitcnt vmcnt(0)" ::: "memory");
        } else {
            XB_SPIN(xb_ld(&bar[XB_XGEN(x)]) == gen, bar);
            __builtin_amdgcn_fence(__ATOMIC_ACQUIRE, "agent");
            asm volatile("s_waitcnt vmcnt(0)" ::: "memory");
        }
    }
    __syncthreads();
}

#ifndef PPL
#define PPL 5
#endif
#ifndef NA_PROBE_SKIP
#define NA_PROBE_SKIP 0
#endif
constexpr int N_PHASES = 1 + PPL * DEPTH;
#ifndef REP0
#define REP0 1
#endif
#ifndef REPN
#define REPN 1
#endif
#ifndef REPS
#define REPS 1
#endif
#ifndef REP2
#define REP2 1
#endif
#ifndef REP3
#define REP3 1
#endif
#ifndef REPP
#define REPP 1
#endif
__global__ void __launch_bounds__(512, 2) fwd(Params p_, int ph_lo, int ph_hi) {
    extern __shared__ __attribute__((aligned(16))) unsigned char shm[];
    LAS unsigned char* lds = (LAS unsigned char*)shm;
    volatile LAS unsigned* xst = (volatile LAS unsigned*)(lds + 131072);
    if (threadIdx.x == 0) { xst[0] = 0u; xst[1] = 0u; }
    if (blockIdx.x == 0 && ph_lo == 0) { unsigned* bar0 = (unsigned*)(p_.ws + WS_BAR); for (int i = threadIdx.x; i < XCD_BAR_WORDS; i += 512) bar0[i] = 0u; }
    __syncthreads();
    for (int ph = ph_lo; ph < ph_hi; ++ph) {
        if (ph != ph_lo) {
            if (ph == 1) { cg::this_grid().sync(); if (threadIdx.x == 0) (void)xb_add(&((unsigned*)(p_.ws + WS_BAR))[XB_XCNT(xb_xcc_id())], 1u); }
            else { const __attribute__((address_space(4))) Params* pb = (const __attribute__((address_space(4))) Params*)__builtin_amdgcn_kernarg_segment_ptr(); xcd_barrier((unsigned*)(pb->ws + WS_BAR), xst); }
        }
        int tid = threadIdx.x; asm volatile("" : "+v"(tid));
        const __attribute__((address_space(4))) Params* pp = (const __attribute__((address_space(4))) Params*)__builtin_amdgcn_kernarg_segment_ptr(); asm volatile("" : "+s"(pp));
        Params p;
        p.x = pp->x; p.pre_g = pp->pre_g; p.post_g = pp->post_g; p.w_in = pp->w_in; p.rpb = pp->rpb; p.ln_g = pp->ln_g; p.ln_b = pp->ln_b; p.sg_w = pp->sg_w; p.sg_b = pp->sg_b;
        p.w_pa = pp->w_pa; p.w_pb = pp->w_pb; p.w_out = pp->w_out; p.out = pp->out; p.ws = pp->ws;
        bf16_t* H = (bf16_t*)(p.ws + WS_H); bf16_t* VT = (bf16_t*)(p.ws + WS_VT); bf16_t* PROJ = (bf16_t*)(p.ws + WS_PROJ);
        float* T1 = (float*)(p.ws + WS_PROJ);
        float* OUT = T1;
        if (ph == 0) { for (int rep = 0; rep < REPP; ++rep) { prologue(p, lds, tid); __syncthreads(); } continue; }
        const int layer = (ph - 1) / PPL, kk = (ph - 1) % PPL, k = (PPL == 6) ? (kk == 0 ? 0 : kk == 1 ? 5 : kk - 1) : kk;
        const unsigned char* wl = p.ws + WS_W + layer * SZ_LAYER_W;
        #if PPL == 6
        if (k == 5) { na_phase<NA_PROBE_SKIP>(p, layer, lds, tid); } else
#endif
        if (k == 1) { na_phase<0>(p, layer, lds, tid); if (k == 1) { sg_phase(p, layer, lds, tid); __syncthreads(); } }
        else if (k == 4) {
            post_rows(layer == 0 ? p.x : p.out, PROJ, p.post_g + layer * DM, p.out, (layer + 1 < DEPTH) ? p.pre_g + (layer + 1) * DM : nullptr, H, tid);
        } else {
            const int njobs = (k == 0) ? 2 : 1, reps = (k == 0) ? REP0 : (k == 2) ? REP2 : REP3;
            for (int jj = 0; jj < njobs * reps; ++jj) { const int j = jj % njobs;
                pg8::Gemm g; pg8::Epi E; E.obf = nullptr; E.ldo = 0; E.sigcol = 0x7fffffff; E.gate = nullptr; E.ldg = 0; E.kt = nullptr;
                if (k == 0 && j == 0) { g.A = H; g.lda = DM; g.Bt = (const bf16_t*)(wl + OFF_WIN); g.ldb = DM; g.M = NTOK; g.N = NP; g.K = DM; E.mode = 0; E.obf = PROJ; E.ldo = NP; E.sigcol = GA_OFF; E.kt = (bf16_t*)(p.ws + WS_KT); }
                else if (k == 0) { g.A = (const bf16_t*)(wl + OFF_WIN) + (size_t)NP * DM; g.lda = DM; g.Bt = H; g.ldb = DM; g.M = 2048; g.N = NTOK; g.K = DM; E.mode = 4; E.obf = VT; E.ldo = 0; }
                else if (k == 2) { g.A = H; g.lda = DM; g.Bt = (const bf16_t*)(wl + OFF_WPA); g.ldb = DM; g.M = NTOK; g.N = DM; g.K = DM; E.mode = 2; E.gate = PROJ + GA_OFF; E.ldg = NP; E.obf = VT; E.ldo = DM; }
                else { g.A = VT; g.lda = DM; g.Bt = (const bf16_t*)(wl + OFF_WOUT); g.ldb = DM; g.M = NTOK; g.N = DM; g.K = DM; E.mode = 0; E.obf = PROJ; E.ldo = DM; }
                pg8::StaticOrder S; S.init(g.M, g.N, (int)gridDim.x, (int)blockIdx.x);
                pg8::gemm_phase(lds, g, S, E, tid);
                __syncthreads();
            }
        }
    }
}

extern "C" void kernel_launch(void* const* d_in, const int* in_sizes, int n_in, void* d_out, int out_size, void* d_ws, size_t ws_size, hipStream_t stream) {
    static int grid = 0;
    if (!grid) {
        if (n_in != 12 || in_sizes[0] != NTOK * DM || out_size != NTOK * DM || ws_size < WS_END) {
            fprintf(stderr, "kernel_launch: unexpected shapes (n_in %d, in0 %d, out %d, ws %zu, need %zu)\n", n_in, n_in > 0 ? in_sizes[0] : -1, out_size, ws_size, (size_t)WS_END); return; }
        int dev = 0, cus = 0, per_cu = 0;
        (void)hipGetDevice(&dev); (void)hipDeviceGetAttribute(&cus, hipDeviceAttributeMultiprocessorCount, dev);
        (void)hipFuncSetAttribute((const void*)fwd, hipFuncAttributeMaxDynamicSharedMemorySize, LDS_BYTES);
        (void)hipOccupancyMaxActiveBlocksPerMultiprocessor(&per_cu, (const void*)fwd, 512, LDS_BYTES);
        if (per_cu < 1) { fprintf(stderr, "kernel_launch: occupancy query says %d blocks per CU\n", per_cu); per_cu = 1; }
        grid = cus * per_cu;
    }
    Params p{};
    p.x = (const float*)d_in[0]; p.pre_g = (const float*)d_in[1]; p.post_g = (const float*)d_in[2]; p.w_in = (const float*)d_in[3]; p.rpb = (const float*)d_in[4];
    p.ln_g = (const float*)d_in[5]; p.ln_b = (const float*)d_in[6]; p.sg_w = (const float*)d_in[7]; p.sg_b = (const float*)d_in[8];
    p.w_pa = (const float*)d_in[9]; p.w_pb = (const float*)d_in[10]; p.w_out = (const float*)d_in[11]; p.out = (float*)d_out; p.ws = (unsigned char*)d_ws;
#ifdef MULTI_LAUNCH
    for (int ph = 0; ph < N_PHASES; ++ph) hipLaunchKernelGGL(fwd, dim3(grid), dim3(512), LDS_BYTES, stream, p, ph, ph + 1);
#else
    int lo = 0, hi = N_PHASES;
    void* args[] = {&p, &lo, &hi};
    hipError_t e = hipLaunchCooperativeKernel((const void*)fwd, dim3(grid), dim3(512), args, LDS_BYTES, stream);
    if (e != hipSuccess) fprintf(stderr, "cooperative launch failed: %s (grid %d)\n", hipGetErrorString(e), grid);
#endif
}
```
